# Optimizing an MI355X kernel written in HIP

```python
import jax, jax.numpy as jnp
from jax import lax
import numpy as np

D_MODEL = 1024
BATCH = 8
SEQ = 2048
DEPTH = 4
DEC_BATCH = 1
DEC_SEQ = 16384
PAST_LEN = 128

MLA_HEADS = 8
MLA_NOPE = 64
MLA_ROPE = 32
MLA_V = 64
Q_LORA = 256
KV_LORA = 128
GQA_HEADS = 8
GQA_KV_HEADS = 2
GQA_DIM = 64
WINDOW = 128
BLOCK = 128
D_FF = 2816
ROPE_THETA = 10000.0
EPS = 1e-6
N_BRANCH = 2
NEG_INF = -1e30
IN_COLS = (Q_LORA + KV_LORA + MLA_ROPE + GQA_HEADS * GQA_DIM
           + 2 * GQA_KV_HEADS * GQA_DIM + N_BRANCH * D_MODEL)

kernel_name = "hybrid_mla_wingqa_macaron_encoder"


def rmsnorm(x, g):
    xf = x.astype(jnp.float32)
    y = xf * lax.rsqrt(jnp.mean(xf * xf, axis=-1, keepdims=True) + EPS)
    return (y * g.astype(jnp.float32)).astype(x.dtype)


def rope(x, seq_len):
    d = x.shape[-1]
    freqs = ROPE_THETA ** (-jnp.arange(0, d, 2, dtype=jnp.float32) / d)
    ang = jnp.arange(seq_len, dtype=jnp.float32)[:, None] * freqs[None, :]
    cos = jnp.cos(ang)[None, :, None, :].astype(x.dtype)
    sin = jnp.sin(ang)[None, :, None, :].astype(x.dtype)
    x1, x2 = x[..., : d // 2], x[..., d // 2:]
    return jnp.concatenate([x1 * cos - x2 * sin, x2 * cos + x1 * sin], axis=-1)


def swiglu(x, w1, w3, w2):
    return (jax.nn.silu(x @ w1) * (x @ w3)) @ w2


def mla_attention(c_q, c_kv, k_pe_raw, q_norm, kv_norm, w_uq, w_ukv):
    B, S, _ = c_q.shape
    H = MLA_HEADS
    q = (rmsnorm(c_q, q_norm) @ w_uq).reshape(B, S, H, MLA_NOPE + MLA_ROPE)
    q = jnp.concatenate([q[..., :MLA_NOPE], rope(q[..., MLA_NOPE:], S)], axis=-1)
    kv = (rmsnorm(c_kv, kv_norm) @ w_ukv).reshape(B, S, H, MLA_NOPE + MLA_V)
    k_nope, v = kv[..., :MLA_NOPE], kv[..., MLA_NOPE:]
    k_pe = rope(k_pe_raw[:, :, None, :], S)
    k = jnp.concatenate([k_nope, jnp.broadcast_to(k_pe, (B, S, H, MLA_ROPE))], axis=-1)
    scale = (MLA_NOPE + MLA_ROPE) ** -0.5
    nb = S // BLOCK
    qb = q.reshape(B, nb, BLOCK, H, MLA_NOPE + MLA_ROPE).transpose(1, 0, 2, 3, 4)

    def one_block(qi):
        s = jnp.einsum('bqhd,bkhd->bhqk', qi, k).astype(jnp.float32) * scale
        p = jax.nn.softmax(s, axis=-1).astype(v.dtype)
        return jnp.einsum('bhqk,bkhv->bqhv', p, v)

    o = lax.map(one_block, qb)
    return o.transpose(1, 0, 2, 3, 4).reshape(B, S, H * MLA_V)


def windowed_gqa(q, k, v, sink):
    B, S, H, d = q.shape
    KV = GQA_KV_HEADS
    G = H // KV
    nb = S // BLOCK
    q = rope(q, S)
    k = rope(k, S)
    pad = ((0, 0), (BLOCK, BLOCK), (0, 0), (0, 0))
    kb = jnp.pad(k, pad).reshape(B, nb + 2, BLOCK, KV, d)
    vb = jnp.pad(v, pad).reshape(B, nb + 2, BLOCK, KV, d)
    kw = jnp.concatenate([kb[:, :-2], kb[:, 1:-1], kb[:, 2:]], axis=2)
    vw = jnp.concatenate([vb[:, :-2], vb[:, 1:-1], vb[:, 2:]], axis=2)
    qb = q.reshape(B, nb, BLOCK, KV, G, d)
    s = jnp.einsum('bnqkgd,bnpkd->bnkgqp', qb, kw).astype(jnp.float32) * (d ** -0.5)
    blk = jnp.arange(nb)[:, None, None] * BLOCK
    qpos = blk + jnp.arange(BLOCK)[None, :, None]
    kpos = blk - BLOCK + jnp.arange(3 * BLOCK)[None, None, :]
    valid = (jnp.abs(qpos - kpos) <= WINDOW) & (kpos >= 0) & (kpos < S)
    s = jnp.where(valid[None, :, None, None, :, :], s, NEG_INF)
    sink_l = jnp.broadcast_to(sink.astype(jnp.float32).reshape(1, 1, KV, G, 1, 1),
                              s.shape[:-1] + (1,))
    p = jax.nn.softmax(jnp.concatenate([s, sink_l], axis=-1), axis=-1)[..., :-1]
    o = jnp.einsum('bnkgqp,bnpkd->bnqkgd', p.astype(v.dtype), vw)
    return o.reshape(B, S, H * d)


def setup_inputs(seed: int = 0) -> dict:
    key = jax.random.key(seed)
    ks = jax.random.split(key, 24)
    D = D_MODEL

    def w(k, shape, fan_in):
        return jax.random.normal(k, shape, jnp.float32) * (fan_in ** -0.5)

    def gain(k, shape):
        return 1.0 + 0.05 * jax.random.normal(k, shape, jnp.float32)

    return {
        "x_prompt": jax.random.normal(ks[0], (BATCH, SEQ, D), jnp.float32),
        "x_sample": jax.random.normal(ks[1], (DEC_BATCH, DEC_SEQ, D), jnp.float32),
        "ffn1_norm": gain(ks[2], (DEPTH, D)),
        "ffn1_w1": w(ks[3], (DEPTH, D, D_FF), D),
        "ffn1_w3": w(ks[4], (DEPTH, D, D_FF), D),
        "ffn1_w2": w(ks[5], (DEPTH, D_FF, D), D_FF),
        "mix_norm": gain(ks[6], (DEPTH, D)),
        "w_in": w(ks[7], (DEPTH, D, IN_COLS), D),
        "q_norm": gain(ks[8], (DEPTH, Q_LORA)),
        "kv_norm": gain(ks[9], (DEPTH, KV_LORA)),
        "w_uq": w(ks[10], (DEPTH, Q_LORA, MLA_HEADS * (MLA_NOPE + MLA_ROPE)), Q_LORA),
        "w_ukv": w(ks[11], (DEPTH, KV_LORA, MLA_HEADS * (MLA_NOPE + MLA_V)), KV_LORA),
        "w_o_mla": w(ks[12], (DEPTH, MLA_HEADS * MLA_V, D), MLA_HEADS * MLA_V),
        "sink": 0.5 * jax.random.normal(ks[13], (DEPTH, GQA_HEADS), jnp.float32),
        "w_o_gqa": w(ks[14], (DEPTH, GQA_HEADS * GQA_DIM, D), GQA_HEADS * GQA_DIM),
        "w_out": w(ks[15], (DEPTH, D, D), D),
        "ffn2_norm": gain(ks[16], (DEPTH, D)),
        "ffn2_w1": w(ks[17], (DEPTH, D, D_FF), D),
        "ffn2_w3": w(ks[18], (DEPTH, D, D_FF), D),
        "ffn2_w2": w(ks[19], (DEPTH, D_FF, D), D_FF),
        "final_norm": gain(ks[20], (D,)),
    }


def reference(x_prompt, x_sample, ffn1_norm, ffn1_w1, ffn1_w3, ffn1_w2, mix_norm, w_in,
              q_norm, kv_norm, w_uq, w_ukv, w_o_mla, sink, w_o_gqa, w_out,
              ffn2_norm, ffn2_w1, ffn2_w3, ffn2_w2, final_norm):
    sizes = [Q_LORA, KV_LORA, MLA_ROPE, GQA_HEADS * GQA_DIM,
             GQA_KV_HEADS * GQA_DIM, GQA_KV_HEADS * GQA_DIM, D_MODEL, D_MODEL]
    cuts = [int(c) for c in np.cumsum(sizes)[:-1]]

    def layer(x, l):
        B, S, _ = x.shape
        x = x + 0.5 * swiglu(rmsnorm(x, ffn1_norm[l]), ffn1_w1[l], ffn1_w3[l], ffn1_w2[l])
        u = rmsnorm(x, mix_norm[l])
        c_q, c_kv, k_pe, gq, gk, gv, g_a, g_b = jnp.split(u @ w_in[l], cuts, axis=-1)
        a = mla_attention(c_q, c_kv, k_pe, q_norm[l], kv_norm[l], w_uq[l], w_ukv[l]) @ w_o_mla[l]
        b = windowed_gqa(gq.reshape(B, S, GQA_HEADS, GQA_DIM),
                         gk.reshape(B, S, GQA_KV_HEADS, GQA_DIM),
                         gv.reshape(B, S, GQA_KV_HEADS, GQA_DIM), sink[l]) @ w_o_gqa[l]
        merged = jax.nn.sigmoid(g_a) * a + jax.nn.sigmoid(g_b) * b
        x = x + merged @ w_out[l]
        x = x + 0.5 * swiglu(rmsnorm(x, ffn2_norm[l]), ffn2_w1[l], ffn2_w3[l], ffn2_w2[l])
        return x

    def trunk(x):
        for l in range(DEPTH):
            x = layer(x, l)
        return rmsnorm(x, final_norm)

    y_prompt = trunk(x_prompt)
    y_sample = trunk(x_sample)
    return (y_prompt, y_sample)
```

```cpp
#include <hip/hip_runtime.h>
#include <hip/hip_cooperative_groups.h>
#include <cstdio>
#include <cstdint>
namespace cg = cooperative_groups;

#define LAS __attribute__((address_space(3)))
#ifndef ATT32
#define ATT32 0
#endif
typedef unsigned short bf16_t;
typedef short bf16x8 __attribute__((ext_vector_type(8)));
typedef float f32x4 __attribute__((ext_vector_type(4)));
typedef float f32x2 __attribute__((ext_vector_type(2)));
typedef unsigned u32x4 __attribute__((ext_vector_type(4)));
typedef unsigned u32x2 __attribute__((ext_vector_type(2)));
#define GAS __attribute__((address_space(1)))
typedef GAS unsigned char* gptr;

constexpr int MTOK = 32768, DM = 1024, FF = 2816, NL = 4;
constexpr int SEQP = 2048, NPROMPT = 16384, SEQS = 16384;
constexpr float EPS = 1e-6f;
constexpr float LOG2E = 1.4426950408889634f;
constexpr float QS_MLA = 0.10206207261596575f * LOG2E;
constexpr float QS_GQA = 0.125f * LOG2E;
constexpr int NPHASE = 1 + 10 * NL;

constexpr size_t MiB = (size_t)1 << 20;
constexpr size_t WS_TAB32 = 0, WS_TAB64 = 2 * MiB, WS_SS = 6 * MiB, WS_W = 9 * MiB, WS_XB = 54 * MiB, WS_MIX = 118 * MiB;
constexpr size_t MX_CQ = 0, MX_CKV = 16 * MiB, MX_GQ = 32 * MiB, MX_GK = 64 * MiB, MX_GVT = 72 * MiB, MX_GA = 80 * MiB, MX_GB = 144 * MiB,
                 MX_QN = 208 * MiB, MX_QP = 240 * MiB, MX_KN = 256 * MiB, MX_VT = 288 * MiB;
constexpr size_t WS_END = WS_MIX + 320 * MiB;
constexpr size_t W_13A = 0, W_2A = 11 * MiB, W_13B = 16 * MiB + 512 * 1024, W_2B = 27 * MiB + 512 * 1024, W_IN = 33 * MiB, W_GVA = 39 * MiB + 512 * 1024,
                 W_UQ = 40 * MiB, W_KN = 40 * MiB + 384 * 1024, W_VT = 40 * MiB + 512 * 1024, W_OA = 40 * MiB + 640 * 1024, W_OB = 41 * MiB + 640 * 1024, W_OUT = 42 * MiB + 640 * 1024;

typedef __bf16 bf16x2_t __attribute__((ext_vector_type(2)));
__device__ __forceinline__ unsigned cvt_pk_bf16(float lo, float hi) { f32x2 v = {lo, hi}; bf16x2_t b = __builtin_convertvector(v, bf16x2_t); return __builtin_bit_cast(unsigned, b); }
__device__ __forceinline__ u32x4 pack8(f32x4 a, f32x4 b) { u32x4 w; w.x = cvt_pk_bf16(a[0], a[1]); w.y = cvt_pk_bf16(a[2], a[3]); w.z = cvt_pk_bf16(b[0], b[1]); w.w = cvt_pk_bf16(b[2], b[3]); return w; }
__device__ __forceinline__ float bf2f(unsigned short h) { return __uint_as_float((unsigned)h << 16); }
__device__ __forceinline__ void unpack8(u32x4 w, f32x4& a, f32x4& b) {
    a[0] = __uint_as_float(w.x << 16); a[1] = __uint_as_float(w.x & 0xffff0000u); a[2] = __uint_as_float(w.y << 16); a[3] = __uint_as_float(w.y & 0xffff0000u);
    b[0] = __uint_as_float(w.z << 16); b[1] = __uint_as_float(w.z & 0xffff0000u); b[2] = __uint_as_float(w.w << 16); b[3] = __uint_as_float(w.w & 0xffff0000u); }
__device__ __forceinline__ float rstd(float ss, float invn) { float t = ss * invn; asm volatile("" : "+v"(t)); t += EPS; return rsqrtf(t); }
__device__ __forceinline__ int tok_pos(int row) { return row < NPROMPT ? (row & (SEQP - 1)) : row - NPROMPT; }

namespace pg8 {
constexpr int BM = 256, BK = 64, HALF = 128, HTB = HALF * BK * 2, STAGE_BYTES = 8 * HTB, NXCD = 8, WGM = 8;
__host__ __device__ __forceinline__ int lds_byte(int r, int c) { const int st = (r >> 4) * 2 + (c >> 5), rr = r & 15, cc = c & 31, ob = rr * 64 + cc * 2; return st * 1024 + (ob ^ (((ob >> 9) & 1) << 5)); }
__host__ __device__ __forceinline__ void stage_rc(int b, int& R, int& C) { const int st = b / 1024, sb = b % 1024, swz = sb ^ (((sb >> 9) & 1) << 5); R = (st >> 1) * 16 + swz / 64; C = (st & 1) * 32 + (swz % 64) / 2; }
__host__ __device__ __forceinline__ int perm32(int rho) { const int n = rho >> 4, i = rho & 15; return 8 * (i >> 2) + 4 * n + (i & 3); }

struct Unit { int pm, pn; };
struct Gemm { const GAS bf16_t* A; const GAS bf16_t* Bt; int M, N, K, lda, ldb; const GAS bf16_t* A2; const GAS bf16_t* B2t; int nt1; };

struct StaticOrder {
    int nM, nN, nwg, G, c, rev;
    __device__ __forceinline__ void init(int M, int N, int G_, int c_, int rev_ = 0) { nM = M / BM; nN = N / BM; nwg = nM * nN; G = G_; c = c_; rev = rev_; }
    __device__ __forceinline__ bool next(int i, Unit& u) const {
        const long L = (long)i * G + c; if (L >= nwg) return false;
        int wgid = (int)L; { const int q = nwg / NXCD, r = nwg % NXCD, xcd = wgid % NXCD, off = wgid / NXCD; wgid = (xcd < r ? xcd * (q + 1) : r * (q + 1) + (xcd - r) * q) + off; }
        const int nig = WGM * nN, gid = wgid / nig, fm = gid * WGM, gsz = (nM - fm) < WGM ? (nM - fm) : WGM;
        u.pm = fm + ((wgid % nig) % gsz); u.pn = (wgid % nig) / gsz; if (rev) u.pm = nM - 1 - u.pm; return true;
    }
};

template <class Epi>
__device__ __forceinline__ void gemm_phase(LAS unsigned char* lds, const Gemm g, const StaticOrder& S, const Epi& E) {
    int tid = threadIdx.x; asm volatile("" : "+v"(tid));
    const int wid = __builtin_amdgcn_readfirstlane(tid >> 6), lane = tid & 63, wr = wid >> 2, wc = wid & 3, fr = lane & 15, fq = lane >> 4;
    int K = g.K; asm volatile("" : "+s"(K));
    const int nt = K / BK;
    unsigned voffA[2], voffB[2];
#pragma unroll
    for (int i = 0; i < 2; ++i) { int R, C; stage_rc(tid * 16 + i * 8192, R, C); const int Rb = Epi::PERM ? ((R & ~31) + perm32(R & 31)) : R;
        voffA[i] = (unsigned)(R * g.lda + C) * 2u; voffB[i] = (unsigned)(Rb * g.ldb + C) * 2u; }
    const size_t kstep = (size_t)(BK * 2);
    const size_t hstepA = (size_t)HALF * g.lda * 2, hstepB = (size_t)HALF * g.ldb * 2;
    const size_t tstepA = 2 * hstepA, tstepB = 2 * hstepB;
    const unsigned ldsw = (unsigned)wid * 1024u;
    const int aoff = lds_byte(wr * 64 + fr, fq * 8), boff = lds_byte(wc * 32 + fr, fq * 8);
#define PG8_SA(b, h) (((b) * 2 + (h)) * HTB)
#define PG8_SB(b, h) ((4 + (b) * 2 + (h)) * HTB)
#define PG8_STAGE(bufoff, gbase, voff) do { _Pragma("unroll") for (int _i = 0; _i < 2; ++_i) \
        __builtin_amdgcn_global_load_lds((const GAS unsigned*)((const GAS char*)(gbase) + (voff)[_i]), (LAS unsigned*)(lds + (bufoff) + ldsw + _i * 8192), 16, 0, 0); } while (0)
#define PG8_LDA(dst, b, h) do { _Pragma("unroll") for (int m = 0; m < 4; ++m) _Pragma("unroll") for (int k = 0; k < 2; ++k) dst[m][k] = *(const LAS bf16x8*)(lds + PG8_SA(b, h) + aoff + m * 2048 + k * 1024); } while (0)
#define PG8_LDB(dst, b, h) do { _Pragma("unroll") for (int n = 0; n < 2; ++n) _Pragma("unroll") for (int k = 0; k < 2; ++k) dst[n][k] = *(const LAS bf16x8*)(lds + PG8_SB(b, h) + boff + n * 2048 + k * 1024); } while (0)
#define PG8_MMA(ai, bj, At, Bt) do { __builtin_amdgcn_s_setprio(1); _Pragma("unroll") for (int m = 0; m < 4; ++m) _Pragma("unroll") for (int n = 0; n < 2; ++n) _Pragma("unroll") for (int k = 0; k < 2; ++k) \
        acc[ai][bj][m][n] = __builtin_amdgcn_mfma_f32_16x16x32_bf16(Bt[n][k], At[m][k], acc[ai][bj][m][n], 0, 0, 0); __builtin_amdgcn_s_setprio(0); } while (0)
#define PG8_WAIT_V(n) asm volatile("s_waitcnt vmcnt(" #n ")" ::: "memory")
#define PG8_WAIT_L(n) asm volatile("s_waitcnt lgkmcnt(" #n ")" ::: "memory")
#define PG8_BAR __builtin_amdgcn_s_barrier()
#define PG8_SCHED __builtin_amdgcn_sched_barrier(0)
    Unit cur, nxt; int ui = 0;
    if (!S.next(0, cur)) return;
    f32x4 acc[2][2][4][2];
#pragma unroll
    for (int a = 0; a < 2; ++a)
#pragma unroll
        for (int b = 0; b < 2; ++b)
#pragma unroll
            for (int m = 0; m < 4; ++m)
#pragma unroll
                for (int n = 0; n < 2; ++n) acc[a][b][m][n] = (f32x4){0.f, 0.f, 0.f, 0.f};
    bf16x8 At[4][2], B0[2][2], B1[2][2];
    const GAS char* cA = (const GAS char*)g.A + (size_t)cur.pm * tstepA; const GAS char* cB = (const GAS char*)g.Bt + (size_t)cur.pn * tstepB;
    const GAS char* cA2 = cA; const GAS char* cB2 = cB; int nt1 = nt;
    if constexpr (Epi::DUAL) { cA2 = (const GAS char*)g.A2 + (size_t)cur.pm * tstepA; cB2 = (const GAS char*)g.B2t + (size_t)cur.pn * tstepB; nt1 = g.nt1; }
#define PG8_TA(k) ((Epi::DUAL && (k) >= nt1) ? cA2 + (size_t)((k) - nt1) * kstep : cA + (size_t)(k) * kstep)
#define PG8_TB(k) ((Epi::DUAL && (k) >= nt1) ? cB2 + (size_t)((k) - nt1) * kstep : cB + (size_t)(k) * kstep)
    PG8_STAGE(PG8_SB(0, 0), cB, voffB); PG8_STAGE(PG8_SB(0, 1), cB + hstepB, voffB); PG8_STAGE(PG8_SA(0, 0), cA, voffA); PG8_STAGE(PG8_SA(0, 1), cA + hstepA, voffA);
    if (wr == 1) PG8_BAR;
    PG8_WAIT_V(2); PG8_BAR;
    PG8_STAGE(PG8_SB(1, 0), cB + kstep, voffB); PG8_STAGE(PG8_SA(1, 0), cA + kstep, voffA); PG8_STAGE(PG8_SB(1, 1), cB + hstepB + kstep, voffB);
    PG8_WAIT_V(6); PG8_BAR;
    for (;;) {
        const bool has_next = S.next(ui + 1, nxt);
        const GAS char* nA = has_next ? (const GAS char*)g.A + (size_t)nxt.pm * tstepA : cA; const GAS char* nB = has_next ? (const GAS char*)g.Bt + (size_t)nxt.pn * tstepB : cB;
#pragma unroll 1
        for (int t = 0; t < nt; t += 2) {
            const bool last = (t == nt - 2);
            if constexpr (Epi::DUAL) { if (t == nt1) E.mid(acc, cur, wr, wc, fr, fq); }
            const GAS char* a1 = PG8_TA(t + 1);
            const GAS char* a2 = last ? nA : PG8_TA(t + 2); const GAS char* b2 = last ? nB : PG8_TB(t + 2);
            const GAS char* a3 = a2 + kstep; const GAS char* b3 = b2 + kstep;
            PG8_LDB(B0, 0, 0); PG8_LDB(B1, 0, 1); PG8_SCHED; PG8_LDA(At, 0, 0); PG8_STAGE(PG8_SA(1, 1), a1 + hstepA, voffA);
            PG8_WAIT_V(8); PG8_WAIT_L(0); PG8_BAR; PG8_MMA(0, 0, At, B0); PG8_MMA(0, 1, At, B1); PG8_BAR; PG8_SCHED;
            PG8_LDA(At, 0, 1); PG8_STAGE(PG8_SB(0, 0), b2, voffB); PG8_STAGE(PG8_SB(0, 1), b2 + hstepB, voffB); PG8_STAGE(PG8_SA(0, 0), a2, voffA);
            PG8_WAIT_V(8); PG8_WAIT_L(0); PG8_BAR; PG8_MMA(1, 0, At, B0); PG8_MMA(1, 1, At, B1); PG8_BAR; PG8_SCHED;
            PG8_LDB(B0, 1, 0); PG8_LDB(B1, 1, 1); PG8_SCHED; PG8_LDA(At, 1, 0); PG8_STAGE(PG8_SA(0, 1), a2 + hstepA, voffA);
            PG8_WAIT_V(8); PG8_WAIT_L(0); PG8_BAR; PG8_MMA(0, 0, At, B0); PG8_MMA(0, 1, At, B1); PG8_BAR; PG8_SCHED;
            PG8_LDA(At, 1, 1); PG8_STAGE(PG8_SB(1, 0), b3, voffB); PG8_STAGE(PG8_SB(1, 1), b3 + hstepB, voffB); PG8_STAGE(PG8_SA(1, 0), a3, voffA);
            PG8_WAIT_V(8); PG8_WAIT_L(0); PG8_BAR; PG8_MMA(1, 0, At, B0); PG8_MMA(1, 1, At, B1); PG8_BAR; PG8_SCHED;
        }
        if (wr == 0) PG8_BAR;
        E(acc, cur, wr, wc, fr, fq);
        if (!has_next) break;
#pragma unroll
        for (int a = 0; a < 2; ++a)
#pragma unroll
            for (int b = 0; b < 2; ++b)
#pragma unroll
                for (int m = 0; m < 4; ++m)
#pragma unroll
                    for (int n = 0; n < 2; ++n) acc[a][b][m][n] = (f32x4){0.f, 0.f, 0.f, 0.f};
        cur = nxt; cA = nA; cB = nB; ++ui;
        if constexpr (Epi::DUAL) { cA2 = (const GAS char*)g.A2 + (size_t)cur.pm * tstepA; cB2 = (const GAS char*)g.B2t + (size_t)cur.pn * tstepB; }
        if (wr == 1) PG8_BAR;
    }
    PG8_WAIT_V(0);
    PG8_BAR;
#undef PG8_TA
#undef PG8_TB
#undef PG8_SA
#undef PG8_SB
#undef PG8_STAGE
#undef PG8_LDA
#undef PG8_LDB
#undef PG8_MMA
#undef PG8_WAIT_V
#undef PG8_WAIT_L
#undef PG8_BAR
#undef PG8_SCHED
}
}
using pg8::Unit;
typedef const f32x4 (&AccRef)[2][2][4][2];

__device__ __forceinline__ float silu_mul(float a, float b) { return a * __builtin_amdgcn_rcpf(1.0f + __builtin_amdgcn_exp2f(-a * LOG2E)) * b; }
__device__ __forceinline__ float sigmoidf_(float a) { return __builtin_amdgcn_rcpf(1.0f + __builtin_amdgcn_exp2f(-a * LOG2E)); }
__device__ __forceinline__ void rope8(f32x4& v0, f32x4& v1, const GAS f32x2* t) {
    const f32x4 t01 = *(const GAS f32x4*)(t), t23 = *(const GAS f32x4*)(t + 2);
    float a, b;
    a = v0[0]; b = v0[1]; v0[0] = a * t01[0] - b * t01[1]; v0[1] = b * t01[0] + a * t01[1];
    a = v0[2]; b = v0[3]; v0[2] = a * t01[2] - b * t01[3]; v0[3] = b * t01[2] + a * t01[3];
    a = v1[0]; b = v1[1]; v1[0] = a * t23[0] - b * t23[1]; v1[1] = b * t23[0] + a * t23[1];
    a = v1[2]; b = v1[3]; v1[2] = a * t23[2] - b * t23[3]; v1[3] = b * t23[2] + a * t23[3];
}

__device__ __forceinline__ void rope8r(f32x4& v0, f32x4& v1, const f32x4 t01, const f32x4 t23) {
    float a, b;
    a = v0[0]; b = v0[1]; v0[0] = a * t01[0] - b * t01[1]; v0[1] = b * t01[0] + a * t01[1];
    a = v0[2]; b = v0[3]; v0[2] = a * t01[2] - b * t01[3]; v0[3] = b * t01[2] + a * t01[3];
    a = v1[0]; b = v1[1]; v1[0] = a * t23[0] - b * t23[1]; v1[1] = b * t23[0] + a * t23[1];
    a = v1[2]; b = v1[3]; v1[2] = a * t23[2] - b * t23[3]; v1[3] = b * t23[2] + a * t23[3];
}
#define WSP(T, off) ((GAS T*)(ws + (unsigned)(off)))
#define DEFBASE(name, cst) gptr name = ws + (size_t)(cst); asm volatile("" : "+s"(name))
#define AT(T, base, var) ((GAS T*)((base) + (unsigned)(var)))
constexpr unsigned SSP_OFF = (unsigned)WS_SS, SSQP_OFF = (unsigned)(WS_SS + 2 * MiB), SSKVP_OFF = (unsigned)(WS_SS + 2 * MiB + 512 * 1024);
__device__ __forceinline__ float sum16(gptr ws, unsigned off, int row) {
    const GAS f32x4* p = (const GAS f32x4*)((ws + off) + (unsigned)((unsigned)row * 64u));
    const f32x4 a = p[0], b = p[1], c = p[2], d = p[3];
    return (((a[0] + a[1]) + (a[2] + a[3])) + ((b[0] + b[1]) + (b[2] + b[3]))) + (((c[0] + c[1]) + (c[2] + c[3])) + ((d[0] + d[1]) + (d[2] + d[3])));
}
__device__ __forceinline__ float sum4(gptr ws, unsigned off, int row) {
    const f32x4 a = *(const GAS f32x4*)((ws + off) + (unsigned)((unsigned)row * 16u));
    return (a[0] + a[1]) + (a[2] + a[3]);
}
__device__ __forceinline__ u32x2 pack_gate8(f32x4 s0, f32x4 s1) {
    u32x2 w;
    w.x = (unsigned)(s0[0] * 255.f + 0.5f) | ((unsigned)(s0[1] * 255.f + 0.5f) << 8) | ((unsigned)(s0[2] * 255.f + 0.5f) << 16) | ((unsigned)(s0[3] * 255.f + 0.5f) << 24);
    w.y = (unsigned)(s1[0] * 255.f + 0.5f) | ((unsigned)(s1[1] * 255.f + 0.5f) << 8) | ((unsigned)(s1[2] * 255.f + 0.5f) << 16) | ((unsigned)(s1[3] * 255.f + 0.5f) << 24);
    return w;
}
__device__ __forceinline__ void unpack_gate8(u32x2 w, f32x4& a, f32x4& b) {
    const float k = 1.0f / 255.0f;
    a[0] = (float)(w.x & 0xffu) * k; a[1] = (float)((w.x >> 8) & 0xffu) * k; a[2] = (float)((w.x >> 16) & 0xffu) * k; a[3] = (float)(w.x >> 24) * k;
    b[0] = (float)(w.y & 0xffu) * k; b[1] = (float)((w.y >> 8) & 0xffu) * k; b[2] = (float)((w.y >> 16) & 0xffu) * k; b[3] = (float)(w.y >> 24) * k;
}
__device__ __forceinline__ void rs_rows16(gptr ws, int row0, int fq, float invn, float (&rs)[2][4]) {
    f32x4 p[2][4];
#pragma unroll
    for (int ai = 0; ai < 2; ++ai)
#pragma unroll
        for (int m = 0; m < 4; ++m) p[ai][m] = *(const GAS f32x4*)((ws + SSP_OFF) + (unsigned)((row0 + ai * 128 + m * 16) * 64 + fq * 16));
#pragma unroll
    for (int ai = 0; ai < 2; ++ai)
#pragma unroll
        for (int m = 0; m < 4; ++m) { float s = (p[ai][m][0] + p[ai][m][1]) + (p[ai][m][2] + p[ai][m][3]); s += __shfl_xor(s, 16); s += __shfl_xor(s, 32); rs[ai][m] = rstd(s, invn); }
}
__device__ __forceinline__ void rs_rows4(gptr ws, unsigned off, int row0, int fq, float invn, float (&rs)[2][4]) {
    float p[2][4];
#pragma unroll
    for (int ai = 0; ai < 2; ++ai)
#pragma unroll
        for (int m = 0; m < 4; ++m) p[ai][m] = *(const GAS float*)((ws + off) + (unsigned)((row0 + ai * 128 + m * 16) * 16 + fq * 4));
#pragma unroll
    for (int ai = 0; ai < 2; ++ai)
#pragma unroll
        for (int m = 0; m < 4; ++m) { float s = p[ai][m]; s += __shfl_xor(s, 16); s += __shfl_xor(s, 32); rs[ai][m] = rstd(s, invn); }
}
struct EpiSwiglu {
    static constexpr bool PERM = true, DUAL = false;
    gptr ws;
    __device__ __forceinline__ void operator()(AccRef acc, const Unit& u, int wr, int wc, int fr, int fq) const {
        const int row0 = u.pm * 256 + wr * 64 + fr, col0 = u.pn * 128 + wc * 32 + fq * 8;
        DEFBASE(pH, WS_MIX);
        float rs[2][4]; rs_rows16(ws, row0, fq, 1.0f / DM, rs);
#pragma unroll
        for (int ai = 0; ai < 2; ++ai)
#pragma unroll
            for (int m = 0; m < 4; ++m) {
                const int row = row0 + ai * 128 + m * 16; const float r = rs[ai][m];
                f32x4 o0, o1;
#pragma unroll
                for (int j = 0; j < 4; ++j) { o0[j] = silu_mul(acc[ai][0][m][0][j] * r, acc[ai][1][m][0][j] * r); o1[j] = silu_mul(acc[ai][0][m][1][j] * r, acc[ai][1][m][1][j] * r); }
                *AT(u32x4, pH, (unsigned)row * (FF * 2) + col0 * 2) = pack8(o0, o1);
            }
    }
};
struct EpiResid {
    static constexpr bool PERM = true, DUAL = false;
    gptr ws; float scale;
    __device__ __forceinline__ void operator()(AccRef acc, const Unit& u, int wr, int wc, int fr, int fq) const {
        const int row0 = u.pm * 256 + wr * 64 + fr, col0 = u.pn * 256 + wc * 32 + fq * 8;
        DEFBASE(pXB, WS_XB);
        u32x4 xv[2][4][2];
#pragma unroll
        for (int ai = 0; ai < 2; ++ai)
#pragma unroll
            for (int m = 0; m < 4; ++m)
#pragma unroll
                for (int bj = 0; bj < 2; ++bj) xv[ai][m][bj] = *AT(const u32x4, pXB, (unsigned)(row0 + ai * 128 + m * 16) * (DM * 2) + (col0 + bj * 128) * 2);
#pragma unroll
        for (int ai = 0; ai < 2; ++ai)
#pragma unroll
            for (int m = 0; m < 4; ++m) {
                const int row = row0 + ai * 128 + m * 16; float q = 0.f;
#pragma unroll
                for (int bj = 0; bj < 2; ++bj) {
                    f32x4 x0, x1; unpack8(xv[ai][m][bj], x0, x1);
                    x0 = x0 + acc[ai][bj][m][0] * scale; x1 = x1 + acc[ai][bj][m][1] * scale;
                    *AT(u32x4, pXB, (unsigned)row * (DM * 2) + (col0 + bj * 128) * 2) = pack8(x0, x1);
                    q += (x0[0] * x0[0] + x0[1] * x0[1]) + (x0[2] * x0[2] + x0[3] * x0[3]) + (x1[0] * x1[0] + x1[1] * x1[1]) + (x1[2] * x1[2] + x1[3] * x1[3]);
                }
                q += __shfl_xor(q, 16); q += __shfl_xor(q, 32);
                if (fq == 0) *WSP(float, SSP_OFF + (unsigned)row * 64u + (unsigned)(u.pn * 4 + wc) * 4u) = q;
            }
    }
};
struct EpiWin {
    static constexpr bool PERM = true, DUAL = false;
    gptr ws;
    __device__ __forceinline__ void operator()(AccRef acc, const Unit& u, int wr, int wc, int fr, int fq) const {
        const int row0 = u.pm * 256 + wr * 64 + fr; const int pn = u.pn;
        float rs[2][4]; rs_rows16(ws, row0, fq, 1.0f / DM, rs);
        if (pn >= 5) {
            DEFBASE(pb, WS_MIX + MX_GA);
            const unsigned gofs = pn <= 8 ? (unsigned)(pn - 5) * 256u : (unsigned)(MX_GB - MX_GA) + (unsigned)(pn - 9) * 256u;
#pragma unroll
            for (int ai = 0; ai < 2; ++ai)
#pragma unroll
                for (int m = 0; m < 4; ++m)
#pragma unroll
                    for (int bj = 0; bj < 2; ++bj) {
                        const int row = row0 + ai * 128 + m * 16; const f32x4 v0 = acc[ai][bj][m][0] * rs[ai][m], v1 = acc[ai][bj][m][1] * rs[ai][m];
                        f32x4 s0, s1;
#pragma unroll
                        for (int j = 0; j < 4; ++j) { s0[j] = sigmoidf_(v0[j]); s1[j] = sigmoidf_(v1[j]); }
                        *AT(u32x2, pb, gofs + (unsigned)row * 1024 + (bj * 128 + wc * 32 + fq * 8)) = pack_gate8(s0, s1);
                    }
        } else if (pn >= 2) {
            DEFBASE(pt, WS_TAB64);
            gptr pb = ws + (pn == 4 ? (size_t)(WS_MIX + MX_GK) : (size_t)(WS_MIX + MX_GQ) + (size_t)(pn - 2) * 512); asm volatile("" : "+s"(pb));
            const unsigned pitch = pn == 4 ? 256u : 1024u; const float qs = pn == 4 ? 1.0f : QS_GQA;
#pragma unroll
            for (int ai = 0; ai < 2; ++ai) {
                f32x4 tb[4][2];
#pragma unroll
                for (int m = 0; m < 4; ++m) { const GAS f32x4* tp = AT(const f32x4, pt, (unsigned)tok_pos(row0 + ai * 128 + m * 16) * 256 + (wc & 1) * 128 + fq * 32); tb[m][0] = tp[0]; tb[m][1] = tp[1]; }
#pragma unroll
                for (int m = 0; m < 4; ++m)
#pragma unroll
                    for (int bj = 0; bj < 2; ++bj) {
                        if (pn == 4 && bj == 1) continue;
                        const int row = row0 + ai * 128 + m * 16; f32x4 v0 = acc[ai][bj][m][0] * rs[ai][m], v1 = acc[ai][bj][m][1] * rs[ai][m];
                        rope8r(v0, v1, tb[m][0], tb[m][1]);
                        *AT(u32x4, pb, (unsigned)row * pitch + (bj * 128 + wc * 32 + fq * 8) * 2) = pack8(v0 * qs, v1 * qs);
                    }
            }
        } else {
            gptr pb = ws + (pn == 0 ? (size_t)(WS_MIX + MX_CQ) : (size_t)(WS_MIX + MX_CKV)); asm volatile("" : "+s"(pb));
            DEFBASE(pt, WS_TAB32);
#pragma unroll
            for (int ai = 0; ai < 2; ++ai)
#pragma unroll
                for (int m = 0; m < 4; ++m) {
                    const int row = row0 + ai * 128 + m * 16; float q0 = 0.f;
#pragma unroll
                    for (int bj = 0; bj < 2; ++bj) {
                        f32x4 v0 = acc[ai][bj][m][0] * rs[ai][m], v1 = acc[ai][bj][m][1] * rs[ai][m];
                        const int lc = bj * 128 + wc * 32 + fq * 8;
                        if (pn == 0 || bj == 0) {
                            q0 += (v0[0] * v0[0] + v0[1] * v0[1]) + (v0[2] * v0[2] + v0[3] * v0[3]) + (v1[0] * v1[0] + v1[1] * v1[1]) + (v1[2] * v1[2] + v1[3] * v1[3]);
                            *AT(u32x4, pb, (unsigned)row * 512 + lc * 2) = pack8(v0, v1);
                        } else if (wc == 0) {
                            const GAS f32x4* tp = AT(const f32x4, pt, (unsigned)tok_pos(row) * 128 + fq * 32);
                            rope8r(v0, v1, tp[0], tp[1]); *AT(u32x4, pb, (unsigned)row * 512 + lc * 2) = pack8(v0, v1);
                        }
                    }
                    q0 += __shfl_xor(q0, 16); q0 += __shfl_xor(q0, 32);
                    if (fq == 0) *WSP(float, (pn == 0 ? SSQP_OFF : SSKVP_OFF) + (unsigned)row * 16u + (unsigned)wc * 4u) = q0;
                }
        }
    }
};
struct EpiQ {
    static constexpr bool PERM = true, DUAL = false;
    gptr ws;
    __device__ __forceinline__ void operator()(AccRef acc, const Unit& u, int wr, int wc, int fr, int fq) const {
        const int row0 = u.pm * 256 + wr * 64 + fr;
        float rs[2][4]; rs_rows4(ws, SSQP_OFF, row0, fq, 1.0f / 256.0f, rs);
#pragma unroll
        for (int bj = 0; bj < 2; ++bj) {
            const int g = u.pn * 8 + bj * 4 + wc, head = g / 3, part = g - head * 3;
            if (part < 2) {
                DEFBASE(pb, WS_MIX + MX_QN);
                const unsigned co = (unsigned)(head * 64 + part * 32 + fq * 8) * 2;
#pragma unroll
                for (int ai = 0; ai < 2; ++ai)
#pragma unroll
                    for (int m = 0; m < 4; ++m) { const int row = row0 + ai * 128 + m * 16; const float r = rs[ai][m] * QS_MLA;
                        *AT(u32x4, pb, (unsigned)row * 1024 + co) = pack8(acc[ai][bj][m][0] * r, acc[ai][bj][m][1] * r); }
            } else {
                DEFBASE(pt, WS_TAB32); DEFBASE(pb, WS_MIX + MX_QP);
                const unsigned co = (unsigned)(head * 32 + fq * 8) * 2;
#pragma unroll
                for (int ai = 0; ai < 2; ++ai) {
                    f32x4 tb[4][2];
#pragma unroll
                    for (int m = 0; m < 4; ++m) { const GAS f32x4* tp = AT(const f32x4, pt, (unsigned)tok_pos(row0 + ai * 128 + m * 16) * 128 + fq * 32); tb[m][0] = tp[0]; tb[m][1] = tp[1]; }
#pragma unroll
                    for (int m = 0; m < 4; ++m) { const int row = row0 + ai * 128 + m * 16; const float r = rs[ai][m] * QS_MLA;
                        f32x4 v0 = acc[ai][bj][m][0] * r, v1 = acc[ai][bj][m][1] * r;
                        rope8r(v0, v1, tb[m][0], tb[m][1]); *AT(u32x4, pb, (unsigned)row * 512 + co) = pack8(v0, v1); }
                }
            }
        }
    }
};
struct EpiKn {
    static constexpr bool PERM = true, DUAL = false;
    gptr ws;
    __device__ __forceinline__ void operator()(AccRef acc, const Unit& u, int wr, int wc, int fr, int fq) const {
        const int row0 = u.pm * 256 + wr * 64 + fr, col0 = u.pn * 256 + wc * 32 + fq * 8;
        float rs[2][4]; rs_rows4(ws, SSKVP_OFF, row0, fq, 1.0f / 128.0f, rs);
        DEFBASE(pb, WS_MIX + MX_KN);
#pragma unroll
        for (int ai = 0; ai < 2; ++ai)
#pragma unroll
            for (int m = 0; m < 4; ++m) {
                const int row = row0 + ai * 128 + m * 16;
#pragma unroll
                for (int bj = 0; bj < 2; ++bj) *AT(u32x4, pb, (unsigned)row * 1024 + (col0 + bj * 128) * 2) = pack8(acc[ai][bj][m][0] * rs[ai][m], acc[ai][bj][m][1] * rs[ai][m]);
            }
    }
};
struct EpiVt {
    static constexpr bool PERM = false, DUAL = false;
    gptr ws; int wide; float invn; unsigned out_off; int nai;
    __device__ __forceinline__ void operator()(AccRef acc, const Unit& u, int wr, int wc, int fr, int fq) const {
        const int vrow0 = u.pm * 256 + wr * 64 + fr, tok0 = u.pn * 256 + wc * 32;
        gptr pb = ws + out_off; asm volatile("" : "+s"(pb));
        float myrs;
        { const int tok = tok0 + (fr >> 3) * 128 + ((fr >> 2) & 1) * 16 + fq * 4 + (fr & 3);
          float s;
          if (wide) { const GAS f32x4* p = (const GAS f32x4*)((ws + SSP_OFF) + (unsigned)(tok * 64)); const f32x4 a = p[0], b = p[1], c = p[2], d = p[3];
                      s = (((a[0] + a[1]) + (a[2] + a[3])) + ((b[0] + b[1]) + (b[2] + b[3]))) + (((c[0] + c[1]) + (c[2] + c[3])) + ((d[0] + d[1]) + (d[2] + d[3]))); }
          else { const f32x4 a = *(const GAS f32x4*)((ws + SSKVP_OFF) + (unsigned)(tok * 16)); s = (a[0] + a[1]) + (a[2] + a[3]); }
          myrs = rstd(s, invn); }
#pragma unroll
        for (int bj = 0; bj < 2; ++bj) {
            f32x4 sc[2];
#pragma unroll
            for (int n = 0; n < 2; ++n)
#pragma unroll
                for (int j = 0; j < 4; ++j) sc[n][j] = __shfl(myrs, fq * 16 + bj * 8 + n * 4 + j);
#pragma unroll
            for (int ai = 0; ai < 2; ++ai) {
                if (ai < nai) {
#pragma unroll
                    for (int m = 0; m < 4; ++m) {
                        const int vrow = vrow0 + ai * 128 + m * 16;
#if ATT32
#pragma unroll
                        for (int n = 0; n < 2; ++n) { const f32x4 v = acc[ai][bj][m][n] * sc[n]; u32x2 w; w.x = cvt_pk_bf16(v[0], v[1]); w.y = cvt_pk_bf16(v[2], v[3]);
                            *AT(u32x2, pb, (unsigned)vrow * (MTOK * 2) + (tok0 + bj * 128 + n * 16 + 8 * (fq & 1) + 4 * (fq >> 1)) * 2) = w; }
#else
                        *AT(u32x4, pb, (unsigned)vrow * (MTOK * 2) + (tok0 + bj * 128 + fq * 8) * 2) = pack8(acc[ai][bj][m][0] * sc[0], acc[ai][bj][m][1] * sc[1]);
#endif
                    }
                }
            }
        }
    }
};
struct EpiGateDual {
    static constexpr bool PERM = true, DUAL = true;
    gptr ws;
    __device__ __forceinline__ void mid(f32x4 (&acc)[2][2][4][2], const Unit& u, int wr, int wc, int fr, int fq) const {
        const int row0 = u.pm * 256 + wr * 64 + fr, col0 = u.pn * 256 + wc * 32 + fq * 8;
        DEFBASE(pa, WS_MIX + MX_GA); DEFBASE(pg, WS_MIX + MX_GB);
#pragma unroll
        for (int ai = 0; ai < 2; ++ai) {
            u32x2 ga[4][2], gb[4][2];
#pragma unroll
            for (int m = 0; m < 4; ++m)
#pragma unroll
                for (int bj = 0; bj < 2; ++bj) { const unsigned eo = (unsigned)(row0 + ai * 128 + m * 16) * 1024 + (col0 + bj * 128); ga[m][bj] = *AT(const u32x2, pa, eo); gb[m][bj] = *AT(const u32x2, pg, eo); }
#pragma unroll
            for (int m = 0; m < 4; ++m)
#pragma unroll
                for (int bj = 0; bj < 2; ++bj) { f32x4 g0, g1, h0, h1; unpack_gate8(ga[m][bj], g0, g1); unpack_gate8(gb[m][bj], h0, h1);
#pragma unroll
                    for (int j = 0; j < 4; ++j) { acc[ai][bj][m][0][j] *= h0[j] * __builtin_amdgcn_rcpf(fmaxf(g0[j], 1e-30f)); acc[ai][bj][m][1][j] *= h1[j] * __builtin_amdgcn_rcpf(fmaxf(g1[j], 1e-30f)); } }
        }
    }
    __device__ __forceinline__ void operator()(AccRef acc, const Unit& u, int wr, int wc, int fr, int fq) const {
        const int row0 = u.pm * 256 + wr * 64 + fr, col0 = u.pn * 256 + wc * 32 + fq * 8;
        DEFBASE(pa, WS_MIX + MX_GA); DEFBASE(pt, WS_MIX + MX_KN);
        u32x2 ga[2][4][2];
#pragma unroll
        for (int ai = 0; ai < 2; ++ai)
#pragma unroll
            for (int m = 0; m < 4; ++m)
#pragma unroll
                for (int bj = 0; bj < 2; ++bj) ga[ai][m][bj] = *AT(const u32x2, pa, (unsigned)(row0 + ai * 128 + m * 16) * 1024 + (col0 + bj * 128));
#pragma unroll
        for (int ai = 0; ai < 2; ++ai)
#pragma unroll
            for (int m = 0; m < 4; ++m)
#pragma unroll
                for (int bj = 0; bj < 2; ++bj) { f32x4 g0, g1; unpack_gate8(ga[ai][m][bj], g0, g1);
#pragma unroll
                    for (int j = 0; j < 4; ++j) { g0[j] = fmaxf(g0[j], 1e-30f) * acc[ai][bj][m][0][j]; g1[j] = fmaxf(g1[j], 1e-30f) * acc[ai][bj][m][1][j]; }
                    *AT(u32x4, pt, (unsigned)(row0 + ai * 128 + m * 16) * 2048 + (col0 + bj * 128) * 2) = pack8(g0, g1); }
    }
};
template <int MODE> struct EpiGate {
    static constexpr bool PERM = true, DUAL = false;
    gptr ws;
    __device__ __forceinline__ void operator()(AccRef acc, const Unit& u, int wr, int wc, int fr, int fq) const {
        const int row0 = u.pm * 256 + wr * 64 + fr, col0 = u.pn * 256 + wc * 32 + fq * 8;
        DEFBASE(pa, WS_MIX + MX_GA); DEFBASE(pt, WS_MIX + MX_KN); DEFBASE(pg, WS_MIX + MX_GB);
#pragma unroll
        for (int ai = 0; ai < 2; ++ai) {
            u32x4 ga[4][2], gb[4][2];
#pragma unroll
            for (int m = 0; m < 4; ++m)
#pragma unroll
                for (int bj = 0; bj < 2; ++bj) { const unsigned eo = (unsigned)(row0 + ai * 128 + m * 16) * 2048 + (col0 + bj * 128) * 2;
                    ga[m][bj] = *AT(const u32x4, MODE == 0 ? pa : pt, eo); if (MODE == 1) gb[m][bj] = *AT(const u32x4, pg, eo); }
#pragma unroll
            for (int m = 0; m < 4; ++m)
#pragma unroll
                for (int bj = 0; bj < 2; ++bj) { const unsigned eo = (unsigned)(row0 + ai * 128 + m * 16) * 2048 + (col0 + bj * 128) * 2;
                    f32x4 g0, g1; unpack8(ga[m][bj], g0, g1);
                    if (MODE == 0) { g0 = g0 * acc[ai][bj][m][0]; g1 = g1 * acc[ai][bj][m][1]; *AT(u32x4, pt, eo) = pack8(g0, g1); }
                    else { f32x4 h0, h1; unpack8(gb[m][bj], h0, h1); g0 = g0 + h0 * acc[ai][bj][m][0]; g1 = g1 + h1 * acc[ai][bj][m][1]; *AT(u32x4, pa, eo) = pack8(g0, g1); } }
        }
    }
};

#if ATT32
#define ATTN_FN attn_unit32
#else
#define ATTN_FN attn_unit
#endif
__device__ __forceinline__ float max3_asm(float a, float b, float c) { float r; asm("v_max3_f32 %0, %1, %2, %3" : "=v"(r) : "v"(a), "v"(b), "v"(c)); return r; }
constexpr int ATT_BUF = 20480;
template <int NDS, bool GQA>
__device__ __forceinline__ void attn_unit(LAS unsigned char* lds, gptr ws,
        unsigned qa_off, unsigned ldqa, unsigned qb_off, unsigned ldqb,
        int qrow,
        unsigned k0_off, unsigned ldk0, unsigned k1_off, unsigned ldk1,
        unsigned vt_off,
        int kv_lo, int kv_hi,
        float sinkl, unsigned o_off) {
    constexpr float THR = 8.0f;
    int tid = threadIdx.x; asm volatile("" : "+v"(tid));
    const int lane = tid & 63, fr = lane & 15, fq = lane >> 4;
    const int foff = (fr * 64 + fq * 16) ^ ((fr >> 3) << 5);
    constexpr int NPC = 4 * NDS + 8, PPW = (2 * NPC) / 8;
    constexpr int ATT_CH = 2 * ATT_BUF;
    const int wv = __builtin_amdgcn_readfirstlane(tid >> 6);
    unsigned gsrc[PPW]; int pdst[PPW]; unsigned pstr[PPW];
    {
        const int obp = lane * 16, ob = obp ^ (((obp >> 9) & 1) << 5), rr = ob >> 6, cc = (ob & 63) >> 4;
#pragma unroll
        for (int j = 0; j < PPW; ++j) {
            const int pc = wv + 8 * j, tt = pc / NPC, p = pc - tt * NPC;
            if (p < 4 * NDS) { const int kb = p / NDS, ds = p - kb * NDS, row = 64 * tt + 16 * kb + rr;
                if (NDS == 3 && ds == 2) { gsrc[j] = k1_off + (unsigned)(kv_lo + row) * ldk1 + cc * 16; pstr[j] = 128 * ldk1; }
                else { gsrc[j] = k0_off + (unsigned)(kv_lo + row) * ldk0 + ds * 64 + cc * 16; pstr[j] = 128 * ldk0; }
                pdst[j] = tt * ATT_BUF + p * 1024;
            } else { const int v = p - 4 * NDS, db = v >> 1, sl = v & 1;
                gsrc[j] = vt_off + (unsigned)(16 * db + rr) * (MTOK * 2) + (unsigned)(kv_lo + 64 * tt) * 2 + (sl * 4 + cc) * 16; pstr[j] = 256;
                pdst[j] = tt * ATT_BUF + 12288 + v * 1024; }
        }
    }
    bf16x8 qf[2][NDS];
#pragma unroll
    for (int qb = 0; qb < 2; ++qb) {
#pragma unroll
        for (int ds = 0; ds < 2; ++ds) qf[qb][ds] = *WSP(const bf16x8, qa_off + (unsigned)(qb * 16 + fr) * ldqa + ds * 64 + fq * 16);
        if (NDS == 3) qf[qb][NDS - 1] = *WSP(const bf16x8, qb_off + (unsigned)(qb * 16 + fr) * ldqb + fq * 16);
    }
    f32x4 o[4][2];
#pragma unroll
    for (int db = 0; db < 4; ++db) { o[db][0] = (f32x4){0.f, 0.f, 0.f, 0.f}; o[db][1] = (f32x4){0.f, 0.f, 0.f, 0.f}; }
    float NEG = -1e30f; asm volatile("" : "+s"(NEG));
    float mref[2];
    const int nt = (kv_hi - kv_lo) >> 6;
#define ATT_DMA(b) do { _Pragma("unroll") for (int j_ = 0; j_ < PPW; ++j_) { \
        __builtin_amdgcn_global_load_lds((const GAS unsigned*)(ws + gsrc[j_]), (LAS unsigned*)(lds + (b) * ATT_CH + pdst[j_]), 16, 0, 0); gsrc[j_] += pstr[j_]; } } while (0)
#define ATT_WAITBAR(N) asm volatile("s_waitcnt vmcnt(" #N ") lgkmcnt(0)\n\ts_barrier" ::: "memory")
#define ATT_QK(S, bufp, c0, c1) do { \
        _Pragma("unroll") for (int kb = 0; kb < 4; ++kb) { S[kb][0] = (f32x4){c0, c0, c0, c0}; S[kb][1] = (f32x4){c1, c1, c1, c1}; } \
        bf16x8 kf_[NDS][4]; \
        _Pragma("unroll") for (int ds = 0; ds < NDS; ++ds) _Pragma("unroll") for (int kb = 0; kb < 4; ++kb) kf_[ds][kb] = *(const LAS bf16x8*)((bufp) + (kb * NDS + ds) * 1024 + foff); \
        __builtin_amdgcn_sched_barrier(0); \
        _Pragma("unroll") for (int ds = 0; ds < NDS; ++ds) _Pragma("unroll") for (int kb = 0; kb < 4; ++kb) { \
            S[kb][0] = __builtin_amdgcn_mfma_f32_16x16x32_bf16(kf_[ds][kb], qf[0][ds], S[kb][0], 0, 0, 0); \
            S[kb][1] = __builtin_amdgcn_mfma_f32_16x16x32_bf16(kf_[ds][kb], qf[1][ds], S[kb][1], 0, 0, 0); } } while (0)
#define ATT_QKN(S, bufp) do { \
        bf16x8 kf_[NDS][4]; \
        _Pragma("unroll") for (int ds = 0; ds < NDS; ++ds) _Pragma("unroll") for (int kb = 0; kb < 4; ++kb) kf_[ds][kb] = *(const LAS bf16x8*)((bufp) + (kb * NDS + ds) * 1024 + foff); \
        __builtin_amdgcn_sched_barrier(0); \
        _Pragma("unroll") for (int ds = 0; ds < NDS; ++ds) _Pragma("unroll") for (int kb = 0; kb < 4; ++kb) { \
            S[kb][0] = __builtin_amdgcn_mfma_f32_16x16x32_bf16(kf_[ds][kb], qf[0][ds], ds == 0 ? negm0 : S[kb][0], 0, 0, 0); \
            S[kb][1] = __builtin_amdgcn_mfma_f32_16x16x32_bf16(kf_[ds][kb], qf[1][ds], ds == 0 ? negm1 : S[kb][1], 0, 0, 0); } } while (0)
#define ATT_MASK(S, kv0) do { if (GQA) { _Pragma("unroll") for (int qb = 0; qb < 2; ++qb) { const int qp = qrow + qb * 16 + fr; \
        _Pragma("unroll") for (int kb = 0; kb < 4; ++kb) _Pragma("unroll") for (int j = 0; j < 4; ++j) { const int d = qp - ((kv0) + kb * 16 + fq * 4 + j); if (d > 128 || d < -128) S[kb][qb][j] = NEG; } } } } while (0)
#define MX3(a, b, c) __builtin_fmaxf(__builtin_fmaxf((a), (b)), (c))
#define ATT_LMAX(S, qb) __builtin_fmaxf(MX3(MX3(MX3(S[0][qb][0], S[0][qb][1], S[0][qb][2]), S[0][qb][3], S[1][qb][0]), S[1][qb][1], S[1][qb][2]), \
                                        MX3(MX3(MX3(MX3(S[1][qb][3], S[2][qb][0], S[2][qb][1]), S[2][qb][2], S[2][qb][3]), S[3][qb][0], S[3][qb][1]), S[3][qb][2], S[3][qb][3]))
#define MX3A(a, b, c) max3_asm((a), (b), (c))
#define ATT_LMAXA(S, qb) MX3A(MX3A(MX3A(MX3A(S[0][qb][0], S[0][qb][1], S[0][qb][2]), S[0][qb][3], S[1][qb][0]), S[1][qb][1], S[1][qb][2]), S[1][qb][3], \
                              MX3A(MX3A(MX3A(MX3A(S[2][qb][0], S[2][qb][1], S[2][qb][2]), S[2][qb][3], S[3][qb][0]), S[3][qb][1], S[3][qb][2]), S[3][qb][3], S[3][qb][3]))
    ATT_DMA(0); ATT_DMA(1);
    ATT_WAITBAR(0);
    f32x4 sA[4][2], sB[4][2];
    ATT_QK(sA, lds, 0.f, 0.f);
    ATT_MASK(sA, kv_lo);
#pragma unroll
    for (int qb = 0; qb < 2; ++qb) {
        float mx = ATT_LMAX(sA, qb);
        mx = fmaxf(mx, __shfl_xor(mx, 16)); mx = fmaxf(mx, __shfl_xor(mx, 32));
        mref[qb] = (mx < -1e29f) ? 0.f : mx;
#pragma unroll
        for (int kb = 0; kb < 4; ++kb) sA[kb][qb] = sA[kb][qb] - mref[qb];
    }
    f32x4 negm0 = {-mref[0], -mref[0], -mref[0], -mref[0]}, negm1 = {-mref[1], -mref[1], -mref[1], -mref[1]};
    const short one_bf = (fr == 0) ? (short)0x3F80 : (short)0;
    const bf16x8 onesf = {one_bf, one_bf, one_bf, one_bf, one_bf, one_bf, one_bf, one_bf};
    f32x4 lacc[2] = {(f32x4){0.f, 0.f, 0.f, 0.f}, (f32x4){0.f, 0.f, 0.f, 0.f}};
    int cb = 0;
#define ATT_STEP(SC, SN, t, has1, ODD, BAR, ISSUE) do { \
        if (BAR) ATT_WAITBAR(0); \
        LAS unsigned char* bufc = lds + cb * ATT_CH + (ODD ? ATT_BUF : 0); \
        const int cbn = (cb == 2) ? 0 : cb + 1; \
        if (ISSUE) ATT_DMA((cb == 0) ? 2 : cb - 1); \
        if (has1) ATT_QKN(SN, (ODD ? lds + cbn * ATT_CH : lds + cb * ATT_CH + ATT_BUF)); \
        bf16x8 pf[2][2]; \
        _Pragma("unroll") for (int qb = 0; qb < 2; ++qb) { \
            _Pragma("unroll") for (int kb = 0; kb < 4; ++kb) _Pragma("unroll") for (int j = 0; j < 4; ++j) SC[kb][qb][j] = __builtin_amdgcn_exp2f(SC[kb][qb][j]); \
            _Pragma("unroll") for (int sl = 0; sl < 2; ++sl) pf[qb][sl] = __builtin_bit_cast(bf16x8, pack8(SC[2 * sl][qb], SC[2 * sl + 1][qb])); } \
        if (has1) ATT_MASK(SN, kv_lo + ((t) + 1) * 64); \
        bf16x8 vf_[2][4]; \
        _Pragma("unroll") for (int sl = 0; sl < 2; ++sl) _Pragma("unroll") for (int db = 0; db < 4; ++db) vf_[sl][db] = *(const LAS bf16x8*)(bufc + 12288 + (db * 2 + sl) * 1024 + foff); \
        _Pragma("unroll") for (int sl = 0; sl < 2; ++sl) { \
            _Pragma("unroll") for (int db = 0; db < 4; ++db) { \
                o[db][0] = __builtin_amdgcn_mfma_f32_16x16x32_bf16(vf_[sl][db], pf[0][sl], o[db][0], 0, 0, 0); \
                o[db][1] = __builtin_amdgcn_mfma_f32_16x16x32_bf16(vf_[sl][db], pf[1][sl], o[db][1], 0, 0, 0); } \
            lacc[0] = __builtin_amdgcn_mfma_f32_16x16x32_bf16(onesf, pf[0][sl], lacc[0], 0, 0, 0); \
            lacc[1] = __builtin_amdgcn_mfma_f32_16x16x32_bf16(onesf, pf[1][sl], lacc[1], 0, 0, 0); } \
        if (has1) { \
            const float l0 = ATT_LMAXA(SN, 0), l1 = ATT_LMAXA(SN, 1);     \
            if (__builtin_expect(__any((l0 > THR) || (l1 > THR)), 0)) { \
                _Pragma("unroll") for (int qb = 0; qb < 2; ++qb) { \
                    float mx = qb == 0 ? l0 : l1; \
                    mx = fmaxf(mx, __shfl_xor(mx, 16)); mx = fmaxf(mx, __shfl_xor(mx, 32)); \
                    const float dl = fmaxf(mx, 0.f), f = __builtin_amdgcn_exp2f(-dl); \
                    mref[qb] += dl; lacc[qb] = lacc[qb] * f; if (qb == 0) negm0 = negm0 - dl; else negm1 = negm1 - dl; \
                    _Pragma("unroll") for (int kb = 0; kb < 4; ++kb) SN[kb][qb] = SN[kb][qb] - dl; \
                    _Pragma("unroll") for (int db = 0; db < 4; ++db) o[db][qb] = o[db][qb] * f; } } } \
        if (ODD) cb = cbn; } while (0)
    int t = 0;
    for (; t + 4 < nt; t += 2) {
        ATT_STEP(sA, sB, t, true, false, false, false);
        ATT_STEP(sB, sA, t + 1, true, true, true, true);
    }
    ATT_STEP(sA, sB, t, true, false, false, false);
    ATT_STEP(sB, sA, t + 1, true, true, true, false);
    ATT_STEP(sA, sB, t + 2, true, false, false, false);
    ATT_STEP(sB, sA, t + 3, false, true, false, false);
    ATT_WAITBAR(0);
#undef ATT_STEP
#undef ATT_DMA
#undef ATT_WAITBAR
#undef ATT_QK
#undef ATT_QKN
#undef ATT_MASK
#undef ATT_LMAX
#undef ATT_LMAXA
#undef MX3A
#undef MX3
#pragma unroll
    for (int qb = 0; qb < 2; ++qb) {
        float l = __shfl(lacc[qb][0], fr);
        if (GQA) l += __builtin_amdgcn_exp2f(sinkl - mref[qb]);
        const float rl = 1.0f / l;
#pragma unroll
        for (int db = 0; db < 4; ++db) { const f32x4 v = o[db][qb] * rl; u32x2 w; w.x = cvt_pk_bf16(v[0], v[1]); w.y = cvt_pk_bf16(v[2], v[3]);
            *WSP(u32x2, o_off + (unsigned)(qb * 16 + fr) * ldqa + db * 32 + fq * 8) = w; }
    }
}


typedef float f32x16 __attribute__((ext_vector_type(16)));
template <int NDS, bool GQA>
__device__ __forceinline__ void attn_unit32(LAS unsigned char* lds, gptr ws,
        unsigned qa_off, unsigned ldqa, unsigned qb_off, unsigned ldqb, int qrow,
        unsigned k0_off, unsigned ldk0, unsigned k1_off, unsigned ldk1, unsigned vt_off,
        int kv_lo, int kv_hi, float sinkl, unsigned o_off) {
    constexpr float THR = 8.0f;
    constexpr int NSL = 2 * NDS;
    int tid = threadIdx.x; asm volatile("" : "+v"(tid));
    const int lane = tid & 63, r32 = lane & 31, hi = lane >> 5;
    const int sw = (r32 >> 2) & 3;
    const int foffE = r32 * 64 + ((hi ^ sw) << 4), foffO = r32 * 64 + (((2 + hi) ^ sw) << 4);
    constexpr int NPC = 4 * NDS + 8, PPW = (NPC + 7) / 8;
    const int wv = __builtin_amdgcn_readfirstlane(tid >> 6);
    unsigned gsrc[PPW]; int pdst[PPW]; unsigned pstr[PPW];
#pragma unroll
    for (int j = 0; j < PPW; ++j) {
        int p = wv + 8 * j; if (p >= NPC) p -= 8;
        if (p < 4 * NDS) { const int s = p >> 1, h = p & 1, kb = s / NDS, dp = s - kb * NDS, r = 16 * h + (lane >> 2), c = (lane & 3) ^ ((r >> 2) & 3), row = 32 * kb + r;
            if (NDS == 3 && dp == 2) { gsrc[j] = k1_off + (unsigned)(kv_lo + row) * ldk1 + c * 16; pstr[j] = 64 * ldk1; }
            else { gsrc[j] = k0_off + (unsigned)(kv_lo + row) * ldk0 + dp * 64 + c * 16; pstr[j] = 64 * ldk0; }
            pdst[j] = p * 1024;
        } else { const int v = p - 4 * NDS, s = v >> 1, h = v & 1, db = s >> 1, sp = s & 1, r = 16 * h + (lane >> 2), c = (lane & 3) ^ ((r >> 2) & 3);
            gsrc[j] = vt_off + (unsigned)(32 * db + r) * (MTOK * 2) + (unsigned)kv_lo * 2 + (sp * 4 + c) * 16; pstr[j] = 128;
            pdst[j] = 12288 + v * 1024; }
    }
    bf16x8 qf[NSL];
#pragma unroll
    for (int ds = 0; ds < NSL; ++ds) {
        if (ds < 4) qf[ds] = *WSP(const bf16x8, qa_off + (unsigned)r32 * ldqa + (16 * ds + 8 * hi) * 2);
        else qf[ds] = *WSP(const bf16x8, qb_off + (unsigned)r32 * ldqb + (16 * (ds - 4) + 8 * hi) * 2);
    }
    f32x16 o[2];
#pragma unroll
    for (int i = 0; i < 16; ++i) { o[0][i] = 0.f; o[1][i] = 0.f; }
    float NEG = -1e30f; asm volatile("" : "+s"(NEG));
    float mref;
    const int nt = (kv_hi - kv_lo) >> 6;
#define ATT_DMA(b) do { _Pragma("unroll") for (int j_ = 0; j_ < PPW; ++j_) { \
        __builtin_amdgcn_global_load_lds((const GAS unsigned*)(ws + gsrc[j_]), (LAS unsigned*)(lds + (b) * ATT_BUF + pdst[j_]), 16, 0, 0); gsrc[j_] += pstr[j_]; } } while (0)
#define ATT_WAITBAR(N) asm volatile("s_waitcnt vmcnt(" #N ") lgkmcnt(0)\n\ts_barrier" ::: "memory")
#define ATT_QK(S, bufp, CI) do { \
        bf16x8 kf_[2][NSL]; \
        _Pragma("unroll") for (int kb = 0; kb < 2; ++kb) _Pragma("unroll") for (int ds = 0; ds < NSL; ++ds) kf_[kb][ds] = *(const LAS bf16x8*)((bufp) + (kb * NDS + (ds >> 1)) * 2048 + ((ds & 1) ? foffO : foffE)); \
        __builtin_amdgcn_sched_barrier(0); \
        _Pragma("unroll") for (int ds = 0; ds < NSL; ++ds) _Pragma("unroll") for (int kb = 0; kb < 2; ++kb) \
            S[kb] = __builtin_amdgcn_mfma_f32_32x32x16_bf16(kf_[kb][ds], qf[ds], ds == 0 ? CI : S[kb], 0, 0, 0); } while (0)
#define ATT_MASK(S, kv0) do { if (GQA) { const int qp = qrow + r32; \
        _Pragma("unroll") for (int kb = 0; kb < 2; ++kb) _Pragma("unroll") for (int r = 0; r < 16; ++r) { const int d = qp - ((kv0) + kb * 32 + (r & 3) + 8 * (r >> 2) + 4 * hi); if (d > 128 || d < -128) S[kb][r] = NEG; } } } while (0)
#define MX3(a, b, c) __builtin_fmaxf(__builtin_fmaxf((a), (b)), (c))
#define ATT_LMAX16(V) MX3(MX3(MX3(MX3(MX3(MX3(MX3(V[0], V[1], V[2]), V[3], V[4]), V[5], V[6]), V[7], V[8]), V[9], V[10]), V[11], V[12]), V[13], V[14])
#define ATT_LMAX(S) __builtin_fmaxf(__builtin_fmaxf(ATT_LMAX16(S[0]), S[0][15]), __builtin_fmaxf(ATT_LMAX16(S[1]), S[1][15]))
    ATT_DMA(0); ATT_DMA(1); ATT_DMA(2);
    ATT_WAITBAR(0);
    f32x16 sA[2], sB[2], negm;
#pragma unroll
    for (int i = 0; i < 16; ++i) negm[i] = 0.f;
    ATT_QK(sA, lds, negm);
    ATT_MASK(sA, kv_lo);
    {
        float mx = ATT_LMAX(sA);
        mx = fmaxf(mx, __shfl_xor(mx, 32));
        mref = (mx < -1e29f) ? 0.f : mx;
#pragma unroll
        for (int i = 0; i < 16; ++i) { sA[0][i] -= mref; sA[1][i] -= mref; negm[i] = -mref; }
    }
    const short one_bf = (r32 == 0) ? (short)0x3F80 : (short)0;
    const bf16x8 onesf = {one_bf, one_bf, one_bf, one_bf, one_bf, one_bf, one_bf, one_bf};
    f32x16 lacc;
#pragma unroll
    for (int i = 0; i < 16; ++i) lacc[i] = 0.f;
    int bcur = 0;
#define ATT_STEP(SC, SN, t, has1, ISSUE, WN) do { \
        if (WN) { if (PPW == 3) ATT_WAITBAR(3); else ATT_WAITBAR(2); } else ATT_WAITBAR(0); \
        LAS unsigned char* bufc = lds + bcur * ATT_BUF; \
        if (ISSUE) ATT_DMA((bcur + 3) & 3); \
        if (has1) ATT_QK(SN, lds + ((bcur + 1) & 3) * ATT_BUF, negm); \
        bf16x8 pf[4]; \
        _Pragma("unroll") for (int kb = 0; kb < 2; ++kb) { \
            _Pragma("unroll") for (int r = 0; r < 16; ++r) SC[kb][r] = __builtin_amdgcn_exp2f(SC[kb][r]); \
            _Pragma("unroll") for (int h = 0; h < 2; ++h) { u32x4 w_; w_.x = cvt_pk_bf16(SC[kb][8 * h + 0], SC[kb][8 * h + 1]); w_.y = cvt_pk_bf16(SC[kb][8 * h + 2], SC[kb][8 * h + 3]); \
                w_.z = cvt_pk_bf16(SC[kb][8 * h + 4], SC[kb][8 * h + 5]); w_.w = cvt_pk_bf16(SC[kb][8 * h + 6], SC[kb][8 * h + 7]); pf[2 * kb + h] = __builtin_bit_cast(bf16x8, w_); } } \
        if (has1) ATT_MASK(SN, kv_lo + ((t) + 1) * 64); \
        bf16x8 vf_[2][4]; \
        _Pragma("unroll") for (int db = 0; db < 2; ++db) _Pragma("unroll") for (int sl = 0; sl < 4; ++sl) vf_[db][sl] = *(const LAS bf16x8*)(bufc + 12288 + (db * 2 + (sl >> 1)) * 2048 + ((sl & 1) ? foffO : foffE)); \
        _Pragma("unroll") for (int sl = 0; sl < 4; ++sl) { \
            o[0] = __builtin_amdgcn_mfma_f32_32x32x16_bf16(vf_[0][sl], pf[sl], o[0], 0, 0, 0); \
            o[1] = __builtin_amdgcn_mfma_f32_32x32x16_bf16(vf_[1][sl], pf[sl], o[1], 0, 0, 0); \
            lacc = __builtin_amdgcn_mfma_f32_32x32x16_bf16(onesf, pf[sl], lacc, 0, 0, 0); } \
        if (has1) { \
            const float l0 = ATT_LMAX(SN); \
            if (__builtin_expect(__any(l0 > THR), 0)) { \
                float mx = fmaxf(l0, __shfl_xor(l0, 32)); \
                const float dl = fmaxf(mx, 0.f), f = __builtin_amdgcn_exp2f(-dl); \
                mref += dl; \
                _Pragma("unroll") for (int i = 0; i < 16; ++i) { SN[0][i] -= dl; SN[1][i] -= dl; o[0][i] *= f; o[1][i] *= f; lacc[i] *= f; negm[i] = -mref; } } } \
        bcur = (bcur + 1) & 3; } while (0)
    int t = 0;
    for (; t + 4 < nt; t += 2) {
        ATT_STEP(sA, sB, t, true, true, 1);
        ATT_STEP(sB, sA, t + 1, true, true, 1);
    }
    ATT_STEP(sA, sB, t, true, true, 1);
    ATT_STEP(sB, sA, t + 1, true, false, 1);
    ATT_STEP(sA, sB, t + 2, true, false, 0);
    ATT_STEP(sB, sA, t + 3, false, false, 0);
    ATT_WAITBAR(0);
#undef ATT_STEP
#undef ATT_DMA
#undef ATT_WAITBAR
#undef ATT_QK
#undef ATT_MASK
#undef ATT_LMAX
#undef ATT_LMAX16
#undef MX3
    {
        float l = __shfl(lacc[0], r32);
        if (GQA) l += __builtin_amdgcn_exp2f(sinkl - mref);
        const float rl = 1.0f / l;
#pragma unroll
        for (int db = 0; db < 2; ++db)
#pragma unroll
            for (int g = 0; g < 4; ++g) { u32x2 w; w.x = cvt_pk_bf16(o[db][4 * g] * rl, o[db][4 * g + 1] * rl); w.y = cvt_pk_bf16(o[db][4 * g + 2] * rl, o[db][4 * g + 3] * rl);
                *WSP(u32x2, o_off + (unsigned)r32 * ldqa + (32 * db + 8 * g + 4 * hi) * 2) = w; }
    }
}

struct Args { const float* in[21]; float* out; unsigned char* ws; int ph_lo, ph_hi; };
__device__ __forceinline__ const GAS float* inptr(int i) {
    asm volatile("" : "+s"(i));
    const __attribute__((address_space(4))) unsigned long long* ka = (const __attribute__((address_space(4))) unsigned long long*)__builtin_amdgcn_kernarg_segment_ptr();
    return (const GAS float*)ka[i];
}
__device__ __forceinline__ int prep_col(int kind, int n, int& alt) {
    alt = 0;
    switch (kind) {
    case 0: return n;
    case 1: { const int pn = n >> 8, jj = n & 255; alt = jj >> 7; return 128 * pn + (jj & 127); }
    case 2: {
        if (n < 384) return n;
        if (n < 416) { const int r = n - 384; return 384 + (r >> 1) + ((r & 1) ? 16 : 0); }
        if (n < 512) return -1;
        if (n < 1024) { const int r = n - 512, h = r >> 6, e = r & 63; return 416 + 64 * h + (e >> 1) + ((e & 1) ? 32 : 0); }
        if (n < 1152) { const int r = n - 1024, h = r >> 6, e = r & 63; return 928 + 64 * h + (e >> 1) + ((e & 1) ? 32 : 0); }
        if (n < 1280) return -1;
        return 1184 + (n - 1280); }
    case 3: return n < 128 ? 1056 + n : -1;
    case 4: { const int h = n / 96, e = n - h * 96; if (e < 64) return 96 * h + e; const int r = e - 64; return 96 * h + 64 + (r >> 1) + ((r & 1) ? 16 : 0); }
    case 5: { const int h = n >> 6, e = n & 63; return 128 * h + e; }
    default: { const int h = n >> 6, e = n & 63; return 128 * h + 64 + e; }
    }
}
template <int KIND>
__device__ __forceinline__ void prep_matrix(const GAS float* s0, const GAS float* s1, const GAS float* gain, gptr ws, unsigned dst_off, int K, int pitch, int Nout, LAS float* scr, int gw, int ngw, int lane, int& rot) {
    asm volatile("" : "+s"(dst_off));
    const int nblk = Nout / 32, nitems = (K / 64) * nblk;
    const int first = (gw + ngw - (rot % ngw)) % ngw; rot += nitems;
    for (int it = first; it < nitems; it += ngw) {
        const int kb = it / nblk, nb = it - kb * nblk, k0 = 64 * kb, n0 = 32 * nb;
        int alt; const int col = prep_col(KIND, n0 + (lane & 31), alt);
        const GAS float* sp = (KIND == 1 && alt) ? s1 : s0;
        float vals[32];
        const GAS float* spk = sp + (size_t)(k0 + (lane >> 5)) * pitch + (col >= 0 ? col : 0);
#pragma unroll
        for (int i = 0; i < 32; ++i) vals[i] = spk[(size_t)(2 * i) * pitch];
        const float g0 = gain ? 0.f : 1.f;
#pragma unroll
        for (int i = 0; i < 32; ++i) { const int kk = 2 * i + (lane >> 5); float v = vals[i] * (gain ? gain[k0 + kk] : 1.0f); if (col < 0) v = g0 * 0.f; scr[kk * 33 + (lane & 31)] = v; }
        asm volatile("s_waitcnt lgkmcnt(0)" ::: "memory");
        const int c = lane & 7;
#pragma unroll
        for (int q = 0; q < 4; ++q) { const int n = (lane >> 3) + 8 * q; const LAS float* s = scr + (8 * c) * 33 + n;
            u32x4 o; o.x = cvt_pk_bf16(s[0 * 33], s[1 * 33]); o.y = cvt_pk_bf16(s[2 * 33], s[3 * 33]); o.z = cvt_pk_bf16(s[4 * 33], s[5 * 33]); o.w = cvt_pk_bf16(s[6 * 33], s[7 * 33]);
            *WSP(u32x4, dst_off + ((unsigned)(n0 + n) * K + k0 + 8 * c) * 2) = o; }
        asm volatile("s_waitcnt lgkmcnt(0)" ::: "memory");
    }
}

__device__ __forceinline__ void prep_layer(gptr ws, int l, LAS float* scr, int gw, int ngw, int lane) {
    const size_t oF = (size_t)l * DM * FF, oD = (size_t)l * DM;
    int rot = 0;
    prep_matrix<1>(inptr(3) + oF, inptr(4) + oF, inptr(2) + oD, ws, WS_W + W_13A, DM, FF, 2 * FF, scr, gw, ngw, lane, rot);
    prep_matrix<0>(inptr(5) + oF, nullptr, nullptr, ws, WS_W + W_2A, FF, DM, DM, scr, gw, ngw, lane, rot);
    prep_matrix<1>(inptr(17) + oF, inptr(18) + oF, inptr(16) + oD, ws, WS_W + W_13B, DM, FF, 2 * FF, scr, gw, ngw, lane, rot);
    prep_matrix<0>(inptr(19) + oF, nullptr, nullptr, ws, WS_W + W_2B, FF, DM, DM, scr, gw, ngw, lane, rot);
    prep_matrix<2>(inptr(7) + (size_t)l * DM * 3232, nullptr, inptr(6) + oD, ws, WS_W + W_IN, DM, 3232, 3328, scr, gw, ngw, lane, rot);
    prep_matrix<3>(inptr(7) + (size_t)l * DM * 3232, nullptr, inptr(6) + oD, ws, WS_W + W_GVA, DM, 3232, 256, scr, gw, ngw, lane, rot);
    prep_matrix<4>(inptr(10) + (size_t)l * 256 * 768, nullptr, inptr(8) + (size_t)l * 256, ws, WS_W + W_UQ, 256, 768, 768, scr, gw, ngw, lane, rot);
    prep_matrix<5>(inptr(11) + (size_t)l * 128 * 1024, nullptr, inptr(9) + (size_t)l * 128, ws, WS_W + W_KN, 128, 1024, 512, scr, gw, ngw, lane, rot);
    prep_matrix<6>(inptr(11) + (size_t)l * 128 * 1024, nullptr, inptr(9) + (size_t)l * 128, ws, WS_W + W_VT, 128, 1024, 512, scr, gw, ngw, lane, rot);
    prep_matrix<0>(inptr(12) + (size_t)l * 512 * 1024, nullptr, nullptr, ws, WS_W + W_OA, 512, 1024, 1024, scr, gw, ngw, lane, rot);
    prep_matrix<0>(inptr(14) + (size_t)l * 512 * 1024, nullptr, nullptr, ws, WS_W + W_OB, 512, 1024, 1024, scr, gw, ngw, lane, rot);
    prep_matrix<0>(inptr(15) + (size_t)l * 1024 * 1024, nullptr, nullptr, ws, WS_W + W_OUT, 1024, 1024, 1024, scr, gw, ngw, lane, rot);
}

__device__ __forceinline__ float wave_sum(float v) {
#pragma unroll
    for (int o = 1; o < 64; o <<= 1) v += __shfl_xor(v, o);
    return v;
}

__device__ const float ROPE_FREQ[48] = {1.000000000e+00f, 5.623413324e-01f, 3.162277639e-01f, 1.778279394e-01f, 1.000000015e-01f, 5.623413250e-02f, 3.162277490e-02f, 1.778279431e-02f, 9.999999776e-03f, 5.623413250e-03f, 3.162277630e-03f, 1.778279431e-03f, 1.000000047e-03f, 5.623413017e-04f, 3.162277571e-04f, 1.778279402e-04f, 1.000000000e+00f, 7.498942614e-01f, 5.623413324e-01f, 4.216965139e-01f, 3.162277639e-01f, 2.371373773e-01f, 1.778279394e-01f, 1.333521307e-01f, 1.000000015e-01f, 7.498941571e-02f, 5.623413250e-02f, 4.216965288e-02f, 3.162277490e-02f, 2.371373773e-02f, 1.778279431e-02f, 1.333521493e-02f, 9.999999776e-03f, 7.498941850e-03f, 5.623413250e-03f, 4.216964822e-03f, 3.162277630e-03f, 2.371373586e-03f, 1.778279431e-03f, 1.333521446e-03f, 1.000000047e-03f, 7.498942432e-04f, 5.623413017e-04f, 4.216965172e-04f, 3.162277571e-04f, 2.371373703e-04f, 1.778279402e-04f, 1.333521504e-04f};

#define XB_TMO      128
#define XB_XCNT(j)  (256  + 64 * (j))
#define XB_XSUB(j)  (1280 + 64 * (j))
#define XB_XGEN(j)  (2304 + 64 * (j))
#define XB_TOP      3328
#define XB_TOPGEN   3392
#define XCD_BAR_WORDS 3456
#define XB_SPIN_CAP (1u << 22)
__device__ __forceinline__ unsigned xb_ld(unsigned* p)              { return __hip_atomic_load(p, __ATOMIC_RELAXED, __HIP_MEMORY_SCOPE_AGENT); }
__device__ __forceinline__ unsigned xb_add(unsigned* p, unsigned v) { return __hip_atomic_fetch_add(p, v, __ATOMIC_RELAXED, __HIP_MEMORY_SCOPE_AGENT); }
__device__ __forceinline__ unsigned xb_xcc_id() { return (unsigned)__builtin_amdgcn_s_getreg((3 << 11) | 20) & 0xFu; }
#define XB_SPIN(cond, bar) do { unsigned _sp = 0; while (cond) { __builtin_amdgcn_s_sleep(1); \
    if ((++_sp & 255u) == 0u) { if (xb_ld(&(bar)[XB_TMO])) break; if (_sp > XB_SPIN_CAP) { atomicAdd(&(bar)[XB_TMO], 1u); break; } } } } while (0)
__device__ __forceinline__ void xcd_barrier_complete(unsigned* bar, unsigned x, unsigned& nloc, unsigned& nx) {
    const unsigned G = gridDim.x * gridDim.y * gridDim.z;
    unsigned sum, cnt, mine, sp = 0u;
    for (;;) {
        sum = 0u; cnt = 0u; mine = 0u;
#pragma unroll
        for (unsigned j = 0; j < 16; ++j) { const unsigned c = xb_ld(&bar[XB_XCNT(j)]); sum += c; cnt += (c > 0u) ? 1u : 0u; mine = (j == x) ? c : mine; }
        if (sum == G) break;
        __builtin_amdgcn_s_sleep(1);
        if ((++sp & 255u) == 0u) { if (xb_ld(&bar[XB_TMO])) break; if (sp > XB_SPIN_CAP) { atomicAdd(&bar[XB_TMO], 1u); break; } }
    }
    nloc = mine > 0u ? mine : 1u; nx = cnt > 0u ? cnt : 1u;
}
__device__ __forceinline__ void xcd_barrier(unsigned* bar, unsigned x, volatile LAS unsigned* st) {
    asm volatile("s_waitcnt vmcnt(0)" ::: "memory");
    __syncthreads();
    if (threadIdx.x == 0) {
        __builtin_amdgcn_s_waitcnt(0);
        unsigned nloc = st[0], nx = st[1];
        if (nloc == 0u) { xcd_barrier_complete(bar, x, nloc, nx); st[0] = nloc; st[1] = nx; }
        const unsigned old = xb_add(&bar[XB_XSUB(x)], 1u);
        const unsigned gen = old / nloc;
        if (old + 1u == (gen + 1u) * nloc) {
            __builtin_amdgcn_fence(__ATOMIC_RELEASE, "agent");
            asm volatile("s_waitcnt vmcnt(0)" ::: "memory");
            const unsigned og = xb_add(&bar[XB_TOP], 1u);
            const unsigned tg = og / nx;
            if (og + 1u == (tg + 1u) * nx) xb_add(&bar[XB_TOPGEN], 1u);
            else XB_SPIN(xb_ld(&bar[XB_TOPGEN]) == tg, bar);
            __builtin_amdgcn_fence(__ATOMIC_ACQUIRE, "agent");
            xb_add(&bar[XB_XGEN(x)], 1u);
            asm volatile("s_waitcnt vmcnt(0)" ::: "memory");
        } else {
            XB_SPIN(xb_ld(&bar[XB_XGEN(x)]) == gen, bar);
            __builtin_amdgcn_fence(__ATOMIC_ACQUIRE, "agent");
            asm volatile("s_waitcnt vmcnt(0)" ::: "memory");
        }
    }
    __syncthreads();
}

constexpr int LDS_BYTES = 131072 + 1024;
constexpr size_t WS_BAR = WS_END;
#ifndef PHMASK
#define PHMASK 0xffff
#endif
#define PHM(b) ((PHMASK & (b)) != 0)
constexpr unsigned SS_OFF(int k) { return (unsigned)(WS_SS + (size_t)k * MTOK * 4); }

__global__ void __launch_bounds__(512) fwd_kernel(Args a) {
    extern __shared__ __attribute__((aligned(16))) unsigned char lds_raw[];
    LAS unsigned char* lds = (LAS unsigned char*)lds_raw;
    cg::grid_group grid = cg::this_grid();
    volatile LAS unsigned* bst = (volatile LAS unsigned*)(lds + 131072);
    if (threadIdx.x < 2) bst[threadIdx.x] = 0u;
    unsigned* barw = (unsigned*)(a.ws + WS_BAR);
    const unsigned myxcc = xb_xcc_id();
    if (threadIdx.x == 0) (void)xb_add(&barw[XB_XCNT(myxcc)], 1u);
    __syncthreads();

    for (int ph = a.ph_lo; ph < a.ph_hi; ++ph) {
        int tid = threadIdx.x, G = gridDim.x, bx = blockIdx.x; asm volatile("" : "+v"(tid), "+s"(G), "+s"(bx));
        gptr ws = (gptr)a.ws; gptr X = (gptr)a.out; asm volatile("" : "+s"(ws), "+s"(X));
        const int lane = tid & 63, wave = __builtin_amdgcn_readfirstlane(tid >> 6);
        const int gw = bx * 8 + wave, ngw = G * 8;
        if (PHM(128) && ph == 0) {
            const GAS float* xp = inptr(0); const GAS float* xs = inptr(1);
            for (int m = gw; m < MTOK; m += ngw) {
                const GAS float* src = (m < NPROMPT) ? xp + (size_t)m * DM : xs + (size_t)(m - NPROMPT) * DM;
                float s = 0.f;
#pragma unroll
                for (int jj = 0; jj < 4; ++jj) { const f32x4 v = *(const GAS f32x4*)(src + jj * 256 + lane * 4);
                    u32x2 w; w.x = cvt_pk_bf16(v[0], v[1]); w.y = cvt_pk_bf16(v[2], v[3]); *WSP(u32x2, WS_XB + (unsigned)m * (DM * 2) + (jj * 256 + lane * 4) * 2) = w;
                    s += (v[0] * v[0] + v[1] * v[1]) + (v[2] * v[2] + v[3] * v[3]); }
                s = wave_sum(s);
                if (lane < 16) *WSP(float, SSP_OFF + (unsigned)m * 64u + lane * 4u) = (lane == 0) ? s : 0.f;
            }
            for (int i = bx * 512 + tid; i < SEQS * 48; i += G * 512) {
                int pos, fi; unsigned dst;
                if (i < SEQS * 16) { pos = i >> 4; fi = i & 15; dst = (unsigned)WS_TAB32 + (unsigned)i * 8u; }
                else { const int k = i - SEQS * 16; pos = k >> 5; fi = 16 + (k & 31); dst = (unsigned)WS_TAB64 + (unsigned)k * 8u; }
                const float ang = (float)pos * ROPE_FREQ[fi];
                const double rev = (double)ang * 0.15915494309189535;
                const float fr_ = (float)(rev - __builtin_rint(rev));
                f32x2 cs; cs.x = __builtin_amdgcn_cosf(fr_); cs.y = __builtin_amdgcn_sinf(fr_); *WSP(f32x2, dst) = cs;
            }
            prep_layer(ws, 0, (LAS float*)(lds + wave * 16384), gw, ngw, lane);
        } else if (ph >= 1000) {
            const int code = ph - 1000;
            unsigned offA, pitA, offB, pitB;
            if (code == 0) { offA = WS_MIX + MX_QN; pitA = 1024; offB = WS_MIX + MX_GQ; pitB = 1024; }
            else if (code == 1) { offA = WS_MIX + MX_KN; pitA = 1024; offB = WS_MIX + MX_QP; pitB = 512; }
            else if (code == 2) { offA = WS_MIX + MX_GA; pitA = 2048; offB = WS_MIX + MX_GB; pitB = 2048; }
            else if (code == 3) { offA = WS_MIX + MX_CQ; pitA = 512; offB = WS_MIX + MX_CKV; pitB = 512; }
            else { offA = WS_MIX + MX_VT; pitA = 1024; offB = WS_MIX + MX_GVT; pitB = 256; }
            for (int m = gw; m < MTOK; m += ngw) {
#pragma unroll
                for (int half = 0; half < 2; ++half) {
                    const unsigned so = (half ? offB + (unsigned)m * pitB : offA + (unsigned)m * pitA) + lane * 16;
                    const u32x4 w = *WSP(const u32x4, so); f32x4 a0, a1; unpack8(w, a0, a1);
                    GAS f32x4* dp = (GAS f32x4*)(X + (unsigned)(m * 4096 + half * 2048 + lane * 32)); dp[0] = a0; dp[1] = a1;
                }
            }
        } else if (ph == NPHASE - 1) {
            const GAS float* g = inptr(20);
            for (int m = gw; m < MTOK; m += ngw) {
                const float rs = rstd(sum16(ws, SSP_OFF, m), 1.0f / DM);
#pragma unroll
                for (int jj = 0; jj < 4; ++jj) { GAS f32x4* p = (GAS f32x4*)(X + (unsigned)(m * (DM * 4) + (jj * 256 + lane * 4) * 4)); const f32x4 gv = *(const GAS f32x4*)(g + jj * 256 + lane * 4);
                    const u32x2 w = *WSP(const u32x2, WS_XB + (unsigned)m * (DM * 2) + (jj * 256 + lane * 4) * 2);
                    f32x4 xv; xv[0] = __uint_as_float(w.x << 16); xv[1] = __uint_as_float(w.x & 0xffff0000u); xv[2] = __uint_as_float(w.y << 16); xv[3] = __uint_as_float(w.y & 0xffff0000u);
                    *p = xv * rs * gv; }
            }
        } else if (ph > 0) {
            const int l = (ph - 1) / 10, sub = (ph - 1) % 10;
            pg8::StaticOrder S;
            if (PHM(1) && (sub == 0 || sub == 7)) {
                pg8::Gemm g{WSP(const bf16_t, WS_XB), WSP(const bf16_t, WS_W + (sub == 0 ? W_13A : W_13B)), MTOK, 2 * FF, DM, DM, DM}; S.init(MTOK, 2 * FF, G, bx);
                EpiSwiglu E{ws};
                pg8::gemm_phase(lds, g, S, E);
            } else if (PHM(2) && (sub == 1 || sub == 8)) {
                pg8::Gemm g{WSP(const bf16_t, WS_MIX), WSP(const bf16_t, WS_W + (sub == 1 ? W_2A : W_2B)), MTOK, DM, FF, FF, FF}; S.init(MTOK, DM, G, bx, 1);
                EpiResid E{ws, 0.5f};
                pg8::gemm_phase(lds, g, S, E);
            } else if (PHM(4) && sub == 2) {
                { pg8::Gemm g{WSP(const bf16_t, WS_XB), WSP(const bf16_t, WS_W + W_IN), MTOK, 3328, DM, DM, DM}; S.init(MTOK, 3328, G, bx);
                  EpiWin E{ws};
                  pg8::gemm_phase(lds, g, S, E); }
                { pg8::Gemm g{WSP(const bf16_t, WS_W + W_GVA), WSP(const bf16_t, WS_XB), 256, MTOK, DM, DM, DM}; S.init(256, MTOK, G, (bx + (G >> 1)) % G);
                  EpiVt E{ws, 1, 1.0f / DM, (unsigned)(WS_MIX + MX_GVT), 1};
                  pg8::gemm_phase(lds, g, S, E); }
            } else if (PHM(8) && sub == 3) {
#ifndef S3
#define S3 7
#endif
                if (S3 & 1) { pg8::Gemm g{WSP(const bf16_t, WS_MIX + MX_CQ), WSP(const bf16_t, WS_W + W_UQ), MTOK, 768, 256, 256, 256}; S.init(MTOK, 768, G, bx);
                  EpiQ E{ws};
                  pg8::gemm_phase(lds, g, S, E); }
                if (S3 & 2) { pg8::Gemm g{WSP(const bf16_t, WS_MIX + MX_CKV), WSP(const bf16_t, WS_W + W_KN), MTOK, 512, 128, 256, 128}; S.init(MTOK, 512, G, bx);
                  EpiKn E{ws};
                  pg8::gemm_phase(lds, g, S, E); }
                if (S3 & 4) { pg8::Gemm g{WSP(const bf16_t, WS_W + W_VT), WSP(const bf16_t, WS_MIX + MX_CKV), 512, MTOK, 128, 128, 256}; S.init(512, MTOK, G, bx);
                  EpiVt E{ws, 0, 1.0f / 128.0f, (unsigned)(WS_MIX + MX_VT), 2};
                  pg8::gemm_phase(lds, g, S, E); }
            } else if (PHM(16) && sub == 4) {
#ifndef ATT_REPS
#define ATT_REPS 1
#endif
                for (int rep = 0; rep < ATT_REPS; ++rep) {
                const int xcd = bx & 7, idx = bx >> 3, per = G >> 3;
                const int h = xcd;
                for (int u = idx; u < 128; u += per) {
                    int row, lo, hi;
                    if (u < 64) { row = NPROMPT + u * 256 + wave * 32; lo = NPROMPT; hi = MTOK; }
                    else { const int v = u - 64, sq = v >> 3; row = sq * SEQP + (v & 7) * 256 + wave * 32; lo = sq * SEQP; hi = lo + SEQP; }
                    ATTN_FN<3, false>(lds, ws, (unsigned)(WS_MIX + MX_QN) + (unsigned)row * 1024 + h * 128, 1024, (unsigned)(WS_MIX + MX_QP) + (unsigned)row * 512 + h * 64, 512, row,
                        (unsigned)(WS_MIX + MX_KN) + h * 128, 1024, (unsigned)(WS_MIX + MX_CKV) + 256, 512, (unsigned)(WS_MIX + MX_VT) + (unsigned)(h * 64) * (MTOK * 2), lo, hi, 0.f, (rep == 0 && ATT_REPS > 1) ? (unsigned)WS_XB + (unsigned)row * 1024 + h * 128 : (unsigned)(WS_MIX + MX_QN) + (unsigned)row * 1024 + h * 128);
                }
                const GAS float* sink = inptr(13) + l * 8;
                for (int u = bx; u < 1024; u += G) {
                    const int blk = u >> 2, kh = (u >> 1) & 1, hp = u & 1, head = kh * 4 + hp * 2 + (wave >> 2);
                    const int q0 = blk * 128, row = q0 + (wave & 3) * 32;
                    const int s_lo = q0 < NPROMPT ? (q0 & ~(SEQP - 1)) : NPROMPT, s_hi = q0 < NPROMPT ? s_lo + SEQP : MTOK;
                    const int lo = (q0 - 128 > s_lo) ? q0 - 128 : s_lo, hi = (q0 + 256 < s_hi) ? q0 + 256 : s_hi;
                    ATTN_FN<2, true>(lds, ws, (unsigned)(WS_MIX + MX_GQ) + (unsigned)row * 1024 + head * 128, 1024, 0, 0, row,
                        (unsigned)(WS_MIX + MX_GK) + kh * 128, 256, 0, 0, (unsigned)(WS_MIX + MX_GVT) + (unsigned)(kh * 64) * (MTOK * 2), lo, hi, sink[head] * LOG2E, (rep == 0 && ATT_REPS > 1) ? (unsigned)(WS_XB + 32 * MiB) + (unsigned)row * 1024 + head * 128 : (unsigned)(WS_MIX + MX_GQ) + (unsigned)row * 1024 + head * 128);
                }
                }
            } else if (PHM(32) && sub == 5) {
                { pg8::Gemm g{WSP(const bf16_t, WS_MIX + MX_GQ), WSP(const bf16_t, WS_W + W_OB), MTOK, DM, 1024, 512, 512, WSP(const bf16_t, WS_MIX + MX_QN), WSP(const bf16_t, WS_W + W_OA), 8}; S.init(MTOK, DM, G, bx);
                  EpiGateDual E{ws};
                  pg8::gemm_phase(lds, g, S, E); }
            } else if (PHM(64) && sub == 6) {
                pg8::Gemm g{WSP(const bf16_t, WS_MIX + MX_KN), WSP(const bf16_t, WS_W + W_OUT), MTOK, DM, DM, DM, DM}; S.init(MTOK, DM, G, bx, 1);
                EpiResid E{ws, 1.0f};
                pg8::gemm_phase(lds, g, S, E);
            } else if (PHM(256) && sub == 9) {
                if (l + 1 < NL) prep_layer(ws, l + 1, (LAS float*)(lds + wave * 16384), gw, ngw, lane);
            }
        }
        if (ph + 1 < a.ph_hi) { if (ph == a.ph_lo) grid.sync(); else xcd_barrier(barw, myxcc, bst); }
    }
}

extern "C" void kernel_launch(void* const* d_in, const int* in_sizes, int n_in, void* d_out, int out_size, void* d_ws, size_t ws_size, hipStream_t stream) {
    static int grid = 0;
    if (grid == 0) {
        if (n_in != 21 || out_size != MTOK * DM || ws_size < WS_END + 65536) { fprintf(stderr, "kernel_launch: unexpected shapes (n_in %d out %d ws %zu)\n", n_in, out_size, ws_size); grid = -1; return; }
        int dev = 0, cus = 0, per_cu = 0;
        (void)hipGetDevice(&dev); (void)hipDeviceGetAttribute(&cus, hipDeviceAttributeMultiprocessorCount, dev);
        (void)hipFuncSetAttribute((const void*)fwd_kernel, hipFuncAttributeMaxDynamicSharedMemorySize, LDS_BYTES);
        (void)hipOccupancyMaxActiveBlocksPerMultiprocessor(&per_cu, (const void*)fwd_kernel, 512, LDS_BYTES);
        (void)hipGetLastError();
        grid = cus;
        if (grid <= 0 || grid % 8 != 0 || grid > 512) grid = 256;
    }
    if (grid < 0) return;
    (void)hipMemsetAsync((char*)d_ws + WS_BAR, 0, 16384, stream);
    Args a{};
    for (int i = 0; i < 21; ++i) a.in[i] = (const float*)d_in[i];
    a.out = (float*)d_out; a.ws = (unsigned char*)d_ws;
#ifndef ONE_LAUNCH
#define ONE_LAUNCH 1
#endif
#if ONE_LAUNCH
    a.ph_lo = 0; a.ph_hi = NPHASE;
    void* args[] = {&a};
    hipError_t e = hipLaunchCooperativeKernel((const void*)fwd_kernel, dim3(grid), dim3(512), args, LDS_BYTES, stream);
    if (e != hipSuccess) fprintf(stderr, "cooperative launch failed: %s (grid %d)\n", hipGetErrorString(e), grid);
#else
#ifndef DBG_STOP
#define DBG_STOP -1
#endif
#ifndef DBG_DUMP
#define DBG_DUMP -1
#endif
    for (int ph = 0; ph < NPHASE; ++ph) {
        if (DBG_STOP >= 0 && ph > DBG_STOP) break;
        a.ph_lo = ph; a.ph_hi = ph + 1;
        hipLaunchKernelGGL(fwd_kernel, dim3(grid), dim3(512), LDS_BYTES, stream, a);
    }
    if (DBG_DUMP >= 0) { a.ph_lo = 1000 + DBG_DUMP; a.ph_hi = a.ph_lo + 1; hipLaunchKernelGGL(fwd_kernel, dim3(grid), dim3(512), LDS_BYTES, stream, a); }
#endif
}
```

```cpp
#include <hip/hip_runtime.h>
#include <hip/hip_cooperative_groups.h>
#include <cstdio>
#include <cstdint>
namespace cg = cooperative_groups;

#define LAS __attribute__((address_space(3)))
#ifndef ATT32
#define ATT32 0
#endif
typedef unsigned short bf16_t;
typedef short bf16x8 __attribute__((ext_vector_type(8)));
typedef float f32x4 __attribute__((ext_vector_type(4)));
typedef float f32x2 __attribute__((ext_vector_type(2)));
typedef unsigned u32x4 __attribute__((ext_vector_type(4)));
typedef unsigned u32x2 __attribute__((ext_vector_type(2)));
#define GAS __attribute__((address_space(1)))
typedef GAS unsigned char* gptr;

constexpr int MTOK = 32768, DM = 1024, FF = 2816, NL = 4;
constexpr int SEQP = 2048, NPROMPT = 16384, SEQS = 16384;
constexpr float EPS = 1e-6f;
constexpr float LOG2E = 1.4426950408889634f;
constexpr float QS_MLA = 0.10206207261596575f * LOG2E;
constexpr float QS_GQA = 0.125f * LOG2E;
constexpr int NPHASE = 2 + 10 * NL;

constexpr size_t MiB = (size_t)1 << 20;
constexpr size_t WS_TAB32 = 0, WS_TAB64 = 2 * MiB, WS_SS = 6 * MiB, WS_W = 9 * MiB, WS_XB = 54 * MiB, WS_MIX = 118 * MiB;
constexpr size_t MX_CQ = 0, MX_CKV = 16 * MiB, MX_GQ = 32 * MiB, MX_GK = 64 * MiB, MX_GVT = 72 * MiB, MX_GA = 80 * MiB, MX_GB = 144 * MiB,
                 MX_QN = 208 * MiB, MX_QP = 240 * MiB, MX_KN = 256 * MiB, MX_VT = 288 * MiB;
constexpr size_t WS_END = WS_MIX + 320 * MiB;
constexpr size_t W_13A = 0, W_2A = 11 * MiB, W_13B = 16 * MiB + 512 * 1024, W_2B = 27 * MiB + 512 * 1024, W_IN = 33 * MiB, W_GVA = 39 * MiB + 512 * 1024,
                 W_UQ = 40 * MiB, W_KN = 40 * MiB + 384 * 1024, W_VT = 40 * MiB + 512 * 1024, W_OA = 40 * MiB + 640 * 1024, W_OB = 41 * MiB + 640 * 1024, W_OUT = 42 * MiB + 640 * 1024;

typedef __bf16 bf16x2_t __attribute__((ext_vector_type(2)));
__device__ __forceinline__ unsigned cvt_pk_bf16(float lo, float hi) { f32x2 v = {lo, hi}; bf16x2_t b = __builtin_convertvector(v, bf16x2_t); return __builtin_bit_cast(unsigned, b); }
__device__ __forceinline__ u32x4 pack8(f32x4 a, f32x4 b) { u32x4 w; w.x = cvt_pk_bf16(a[0], a[1]); w.y = cvt_pk_bf16(a[2], a[3]); w.z = cvt_pk_bf16(b[0], b[1]); w.w = cvt_pk_bf16(b[2], b[3]); return w; }
__device__ __forceinline__ float bf2f(unsigned short h) { return __uint_as_float((unsigned)h << 16); }
__device__ __forceinline__ void unpack8(u32x4 w, f32x4& a, f32x4& b) {
    a[0] = __uint_as_float(w.x << 16); a[1] = __uint_as_float(w.x & 0xffff0000u); a[2] = __uint_as_float(w.y << 16); a[3] = __uint_as_float(w.y & 0xffff0000u);
    b[0] = __uint_as_float(w.z << 16); b[1] = __uint_as_float(w.z & 0xffff0000u); b[2] = __uint_as_float(w.w << 16); b[3] = __uint_as_float(w.w & 0xffff0000u); }
__device__ __forceinline__ float rstd(float ss, float invn) { float t = ss * invn; asm volatile("" : "+v"(t)); t += EPS; return rsqrtf(t); }
__device__ __forceinline__ int tok_pos(int row) { return row < NPROMPT ? (row & (SEQP - 1)) : row - NPROMPT; }

namespace pg8 {
constexpr int BM = 256, BK = 64, HALF = 128, HTB = HALF * BK * 2, STAGE_BYTES = 8 * HTB, NXCD = 8, WGM = 8;
__host__ __device__ __forceinline__ int lds_byte(int r, int c) { const int st = (r >> 4) * 2 + (c >> 5), rr = r & 15, cc = c & 31, ob = rr * 64 + cc * 2; return st * 1024 + (ob ^ (((ob >> 9) & 1) << 5)); }
__host__ __device__ __forceinline__ void stage_rc(int b, int& R, int& C) { const int st = b / 1024, sb = b % 1024, swz = sb ^ (((sb >> 9) & 1) << 5); R = (st >> 1) * 16 + swz / 64; C = (st & 1) * 32 + (swz % 64) / 2; }
__host__ __device__ __forceinline__ int perm32(int rho) { const int n = rho >> 4, i = rho & 15; return 8 * (i >> 2) + 4 * n + (i & 3); }

struct Unit { int pm, pn; };
struct Gemm { const GAS bf16_t* A; const GAS bf16_t* Bt; int M, N, K, lda, ldb; const GAS bf16_t* A2; const GAS bf16_t* B2t; int nt1; };

struct StaticOrder {
    int nM, nN, nwg, G, c, rev;
    __device__ __forceinline__ void init(int M, int N, int G_, int c_, int rev_ = 0) { nM = M / BM; nN = N / BM; nwg = nM * nN; G = G_; c = c_; rev = rev_; }
    __device__ __forceinline__ bool next(int i, Unit& u) const {
        const long L = (long)i * G + c; if (L >= nwg) return false;
        int wgid = (int)L; { const int q = nwg / NXCD, r = nwg % NXCD, xcd = wgid % NXCD, off = wgid / NXCD; wgid = (xcd < r ? xcd * (q + 1) : r * (q + 1) + (xcd - r) * q) + off; }
        const int nig = WGM * nN, gid = wgid / nig, fm = gid * WGM, gsz = (nM - fm) < WGM ? (nM - fm) : WGM;
        u.pm = fm + ((wgid % nig) % gsz); u.pn = (wgid % nig) / gsz; if (rev) u.pm = nM - 1 - u.pm; return true;
    }
};

template <class Epi>
__device__ __forceinline__ void gemm_phase(LAS unsigned char* lds, const Gemm g, const StaticOrder& S, const Epi& E) {
    int tid = threadIdx.x; asm volatile("" : "+v"(tid));
    const int wid = __builtin_amdgcn_readfirstlane(tid >> 6), lane = tid & 63, wr = wid >> 2, wc = wid & 3, fr = lane & 15, fq = lane >> 4;
    int K = g.K; asm volatile("" : "+s"(K));
    const int nt = K / BK;
    unsigned voffA[2], voffB[2];
#pragma unroll
    for (int i = 0; i < 2; ++i) { int R, C; stage_rc(tid * 16 + i * 8192, R, C); const int Rb = Epi::PERM ? ((R & ~31) + perm32(R & 31)) : R;
        voffA[i] = (unsigned)(R * g.lda + C) * 2u; voffB[i] = (unsigned)(Rb * g.ldb + C) * 2u; }
    const size_t kstep = (size_t)(BK * 2);
    const size_t hstepA = (size_t)HALF * g.lda * 2, hstepB = (size_t)HALF * g.ldb * 2;
    const size_t tstepA = 2 * hstepA, tstepB = 2 * hstepB;
    const unsigned ldsw = (unsigned)wid * 1024u;
    const int aoff = lds_byte(wr * 64 + fr, fq * 8), boff = lds_byte(wc * 32 + fr, fq * 8);
#define PG8_SA(b, h) (((b) * 2 + (h)) * HTB)
#define PG8_SB(b, h) ((4 + (b) * 2 + (h)) * HTB)
#define PG8_STAGE(bufoff, gbase, voff) do { _Pragma("unroll") for (int _i = 0; _i < 2; ++_i) \
        __builtin_amdgcn_global_load_lds((const GAS unsigned*)((const GAS char*)(gbase) + (voff)[_i]), (LAS unsigned*)(lds + (bufoff) + ldsw + _i * 8192), 16, 0, 0); } while (0)
#define PG8_LDA(dst, b, h) do { _Pragma("unroll") for (int m = 0; m < 4; ++m) _Pragma("unroll") for (int k = 0; k < 2; ++k) dst[m][k] = *(const LAS bf16x8*)(lds + PG8_SA(b, h) + aoff + m * 2048 + k * 1024); } while (0)
#define PG8_LDB(dst, b, h) do { _Pragma("unroll") for (int n = 0; n < 2; ++n) _Pragma("unroll") for (int k = 0; k < 2; ++k) dst[n][k] = *(const LAS bf16x8*)(lds + PG8_SB(b, h) + boff + n * 2048 + k * 1024); } while (0)
#define PG8_MMA(ai, bj, At, Bt) do { __builtin_amdgcn_s_setprio(1); _Pragma("unroll") for (int m = 0; m < 4; ++m) _Pragma("unroll") for (int n = 0; n < 2; ++n) _Pragma("unroll") for (int k = 0; k < 2; ++k) \
        acc[ai][bj][m][n] = __builtin_amdgcn_mfma_f32_16x16x32_bf16(Bt[n][k], At[m][k], acc[ai][bj][m][n], 0, 0, 0); __builtin_amdgcn_s_setprio(0); } while (0)
#define PG8_WAIT_V(n) asm volatile("s_waitcnt vmcnt(" #n ")" ::: "memory")
#define PG8_WAIT_L(n) asm volatile("s_waitcnt lgkmcnt(" #n ")" ::: "memory")
#define PG8_BAR __builtin_amdgcn_s_barrier()
#define PG8_SCHED __builtin_amdgcn_sched_barrier(0)
    Unit cur, nxt; int ui = 0;
    if (!S.next(0, cur)) return;
    f32x4 acc[2][2][4][2];
#pragma unroll
    for (int a = 0; a < 2; ++a)
#pragma unroll
        for (int b = 0; b < 2; ++b)
#pragma unroll
            for (int m = 0; m < 4; ++m)
#pragma unroll
                for (int n = 0; n < 2; ++n) acc[a][b][m][n] = (f32x4){0.f, 0.f, 0.f, 0.f};
    bf16x8 At[4][2], B0[2][2], B1[2][2];
    const GAS char* cA = (const GAS char*)g.A + (size_t)cur.pm * tstepA; const GAS char* cB = (const GAS char*)g.Bt + (size_t)cur.pn * tstepB;
    const GAS char* cA2 = cA; const GAS char* cB2 = cB; int nt1 = nt;
    if constexpr (Epi::DUAL) { cA2 = (const GAS char*)g.A2 + (size_t)cur.pm * tstepA; cB2 = (const GAS char*)g.B2t + (size_t)cur.pn * tstepB; nt1 = g.nt1; }
#define PG8_TA(k) ((Epi::DUAL && (k) >= nt1) ? cA2 + (size_t)((k) - nt1) * kstep : cA + (size_t)(k) * kstep)
#define PG8_TB(k) ((Epi::DUAL && (k) >= nt1) ? cB2 + (size_t)((k) - nt1) * kstep : cB + (size_t)(k) * kstep)
    PG8_STAGE(PG8_SB(0, 0), cB, voffB); PG8_STAGE(PG8_SB(0, 1), cB + hstepB, voffB); PG8_STAGE(PG8_SA(0, 0), cA, voffA); PG8_STAGE(PG8_SA(0, 1), cA + hstepA, voffA);
    if (wr == 1) PG8_BAR;
    PG8_WAIT_V(2); PG8_BAR;
    PG8_STAGE(PG8_SB(1, 0), cB + kstep, voffB); PG8_STAGE(PG8_SA(1, 0), cA + kstep, voffA); PG8_STAGE(PG8_SB(1, 1), cB + hstepB + kstep, voffB);
    PG8_WAIT_V(6); PG8_BAR;
    for (;;) {
        const bool has_next = S.next(ui + 1, nxt);
        const GAS char* nA = has_next ? (const GAS char*)g.A + (size_t)nxt.pm * tstepA : cA; const GAS char* nB = has_next ? (const GAS char*)g.Bt + (size_t)nxt.pn * tstepB : cB;
#pragma unroll 1
        for (int t = 0; t < nt; t += 2) {
            const bool last = (t == nt - 2);
            if constexpr (Epi::DUAL) { if (t == nt1) E.mid(acc, cur, wr, wc, fr, fq); }
            const GAS char* a1 = PG8_TA(t + 1);
            const GAS char* a2 = last ? nA : PG8_TA(t + 2); const GAS char* b2 = last ? nB : PG8_TB(t + 2);
            const GAS char* a3 = a2 + kstep; const GAS char* b3 = b2 + kstep;
            PG8_LDB(B0, 0, 0); PG8_LDB(B1, 0, 1); PG8_SCHED; PG8_LDA(At, 0, 0); PG8_STAGE(PG8_SA(1, 1), a1 + hstepA, voffA);
            PG8_WAIT_V(8); PG8_WAIT_L(0); PG8_BAR; PG8_MMA(0, 0, At, B0); PG8_MMA(0, 1, At, B1); PG8_BAR; PG8_SCHED;
            PG8_LDA(At, 0, 1); PG8_STAGE(PG8_SB(0, 0), b2, voffB); PG8_STAGE(PG8_SB(0, 1), b2 + hstepB, voffB); PG8_STAGE(PG8_SA(0, 0), a2, voffA);
            PG8_WAIT_V(8); PG8_WAIT_L(0); PG8_BAR; PG8_MMA(1, 0, At, B0); PG8_MMA(1, 1, At, B1); PG8_BAR; PG8_SCHED;
            PG8_LDB(B0, 1, 0); PG8_LDB(B1, 1, 1); PG8_SCHED; PG8_LDA(At, 1, 0); PG8_STAGE(PG8_SA(0, 1), a2 + hstepA, voffA);
            PG8_WAIT_V(8); PG8_WAIT_L(0); PG8_BAR; PG8_MMA(0, 0, At, B0); PG8_MMA(0, 1, At, B1); PG8_BAR; PG8_SCHED;
            PG8_LDA(At, 1, 1); PG8_STAGE(PG8_SB(1, 0), b3, voffB); PG8_STAGE(PG8_SB(1, 1), b3 + hstepB, voffB); PG8_STAGE(PG8_SA(1, 0), a3, voffA);
            PG8_WAIT_V(8); PG8_WAIT_L(0); PG8_BAR; PG8_MMA(1, 0, At, B0); PG8_MMA(1, 1, At, B1); PG8_BAR; PG8_SCHED;
        }
        if (wr == 0) PG8_BAR;
        E(acc, cur, wr, wc, fr, fq);
        if (!has_next) break;
#pragma unroll
        for (int a = 0; a < 2; ++a)
#pragma unroll
            for (int b = 0; b < 2; ++b)
#pragma unroll
                for (int m = 0; m < 4; ++m)
#pragma unroll
                    for (int n = 0; n < 2; ++n) acc[a][b][m][n] = (f32x4){0.f, 0.f, 0.f, 0.f};
        cur = nxt; cA = nA; cB = nB; ++ui;
        if constexpr (Epi::DUAL) { cA2 = (const GAS char*)g.A2 + (size_t)cur.pm * tstepA; cB2 = (const GAS char*)g.B2t + (size_t)cur.pn * tstepB; }
        if (wr == 1) PG8_BAR;
    }
    PG8_WAIT_V(0);
    PG8_BAR;
#undef PG8_TA
#undef PG8_TB
#undef PG8_SA
#undef PG8_SB
#undef PG8_STAGE
#undef PG8_LDA
#undef PG8_LDB
#undef PG8_MMA
#undef PG8_WAIT_V
#undef PG8_WAIT_L
#undef PG8_BAR
#undef PG8_SCHED
}
}
using pg8::Unit;
typedef const f32x4 (&AccRef)[2][2][4][2];

__device__ __forceinline__ float silu_mul(float a, float b) { return a * __builtin_amdgcn_rcpf(1.0f + __builtin_amdgcn_exp2f(-a * LOG2E)) * b; }
__device__ __forceinline__ float sigmoidf_(float a) { return __builtin_amdgcn_rcpf(1.0f + __builtin_amdgcn_exp2f(-a * LOG2E)); }
__device__ __forceinline__ void rope8(f32x4& v0, f32x4& v1, const GAS f32x2* t) {
    const f32x4 t01 = *(const GAS f32x4*)(t), t23 = *(const GAS f32x4*)(t + 2);
    float a, b;
    a = v0[0]; b = v0[1]; v0[0] = a * t01[0] - b * t01[1]; v0[1] = b * t01[0] + a * t01[1];
    a = v0[2]; b = v0[3]; v0[2] = a * t01[2] - b * t01[3]; v0[3] = b * t01[2] + a * t01[3];
    a = v1[0]; b = v1[1]; v1[0] = a * t23[0] - b * t23[1]; v1[1] = b * t23[0] + a * t23[1];
    a = v1[2]; b = v1[3]; v1[2] = a * t23[2] - b * t23[3]; v1[3] = b * t23[2] + a * t23[3];
}

__device__ __forceinline__ void rope8r(f32x4& v0, f32x4& v1, const f32x4 t01, const f32x4 t23) {
    float a, b;
    a = v0[0]; b = v0[1]; v0[0] = a * t01[0] - b * t01[1]; v0[1] = b * t01[0] + a * t01[1];
    a = v0[2]; b = v0[3]; v0[2] = a * t01[2] - b * t01[3]; v0[3] = b * t01[2] + a * t01[3];
    a = v1[0]; b = v1[1]; v1[0] = a * t23[0] - b * t23[1]; v1[1] = b * t23[0] + a * t23[1];
    a = v1[2]; b = v1[3]; v1[2] = a * t23[2] - b * t23[3]; v1[3] = b * t23[2] + a * t23[3];
}
#define WSP(T, off) ((GAS T*)(ws + (unsigned)(off)))
#define DEFBASE(name, cst) gptr name = ws + (size_t)(cst); asm volatile("" : "+s"(name))
#define AT(T, base, var) ((GAS T*)((base) + (unsigned)(var)))
constexpr unsigned SSP_OFF = (unsigned)WS_SS, SSQP_OFF = (unsigned)(WS_SS + 2 * MiB), SSKVP_OFF = (unsigned)(WS_SS + 2 * MiB + 512 * 1024);
__device__ __forceinline__ float sum16(gptr ws, unsigned off, int row) {
    const GAS f32x4* p = (const GAS f32x4*)((ws + off) + (unsigned)((unsigned)row * 64u));
    const f32x4 a = p[0], b = p[1], c = p[2], d = p[3];
    return (((a[0] + a[1]) + (a[2] + a[3])) + ((b[0] + b[1]) + (b[2] + b[3]))) + (((c[0] + c[1]) + (c[2] + c[3])) + ((d[0] + d[1]) + (d[2] + d[3])));
}
__device__ __forceinline__ float sum4(gptr ws, unsigned off, int row) {
    const f32x4 a = *(const GAS f32x4*)((ws + off) + (unsigned)((unsigned)row * 16u));
    return (a[0] + a[1]) + (a[2] + a[3]);
}
__device__ __forceinline__ void rs_rows16(gptr ws, int row0, int fq, float invn, float (&rs)[2][4]) {
    f32x4 p[2][4];
#pragma unroll
    for (int ai = 0; ai < 2; ++ai)
#pragma unroll
        for (int m = 0; m < 4; ++m) p[ai][m] = *(const GAS f32x4*)((ws + SSP_OFF) + (unsigned)((row0 + ai * 128 + m * 16) * 64 + fq * 16));
#pragma unroll
    for (int ai = 0; ai < 2; ++ai)
#pragma unroll
        for (int m = 0; m < 4; ++m) { float s = (p[ai][m][0] + p[ai][m][1]) + (p[ai][m][2] + p[ai][m][3]); s += __shfl_xor(s, 16); s += __shfl_xor(s, 32); rs[ai][m] = rstd(s, invn); }
}
__device__ __forceinline__ void rs_rows4(gptr ws, unsigned off, int row0, int fq, float invn, float (&rs)[2][4]) {
    float p[2][4];
#pragma unroll
    for (int ai = 0; ai < 2; ++ai)
#pragma unroll
        for (int m = 0; m < 4; ++m) p[ai][m] = *(const GAS float*)((ws + off) + (unsigned)((row0 + ai * 128 + m * 16) * 16 + fq * 4));
#pragma unroll
    for (int ai = 0; ai < 2; ++ai)
#pragma unroll
        for (int m = 0; m < 4; ++m) { float s = p[ai][m]; s += __shfl_xor(s, 16); s += __shfl_xor(s, 32); rs[ai][m] = rstd(s, invn); }
}
struct EpiSwiglu {
    static constexpr bool PERM = true, DUAL = false;
    gptr ws;
    __device__ __forceinline__ void operator()(AccRef acc, const Unit& u, int wr, int wc, int fr, int fq) const {
        const int row0 = u.pm * 256 + wr * 64 + fr, col0 = u.pn * 128 + wc * 32 + fq * 8;
        DEFBASE(pH, WS_MIX);
        float rs[2][4]; rs_rows16(ws, row0, fq, 1.0f / DM, rs);
#pragma unroll
        for (int ai = 0; ai < 2; ++ai)
#pragma unroll
            for (int m = 0; m < 4; ++m) {
                const int row = row0 + ai * 128 + m * 16; const float r = rs[ai][m];
                f32x4 o0, o1;
#pragma unroll
                for (int j = 0; j < 4; ++j) { o0[j] = silu_mul(acc[ai][0][m][0][j] * r, acc[ai][1][m][0][j] * r); o1[j] = silu_mul(acc[ai][0][m][1][j] * r, acc[ai][1][m][1][j] * r); }
                *AT(u32x4, pH, (unsigned)row * (FF * 2) + col0 * 2) = pack8(o0, o1);
            }
    }
};
struct EpiResid {
    static constexpr bool PERM = true, DUAL = false;
    gptr ws; float scale;
    __device__ __forceinline__ void operator()(AccRef acc, const Unit& u, int wr, int wc, int fr, int fq) const {
        const int row0 = u.pm * 256 + wr * 64 + fr, col0 = u.pn * 256 + wc * 32 + fq * 8;
        DEFBASE(pXB, WS_XB);
        u32x4 xv[2][4][2];
#pragma unroll
        for (int ai = 0; ai < 2; ++ai)
#pragma unroll
            for (int m = 0; m < 4; ++m)
#pragma unroll
                for (int bj = 0; bj < 2; ++bj) xv[ai][m][bj] = *AT(const u32x4, pXB, (unsigned)(row0 + ai * 128 + m * 16) * (DM * 2) + (col0 + bj * 128) * 2);
#pragma unroll
        for (int ai = 0; ai < 2; ++ai)
#pragma unroll
            for (int m = 0; m < 4; ++m) {
                const int row = row0 + ai * 128 + m * 16; float q = 0.f;
#pragma unroll
                for (int bj = 0; bj < 2; ++bj) {
                    f32x4 x0, x1; unpack8(xv[ai][m][bj], x0, x1);
                    x0 = x0 + acc[ai][bj][m][0] * scale; x1 = x1 + acc[ai][bj][m][1] * scale;
                    *AT(u32x4, pXB, (unsigned)row * (DM * 2) + (col0 + bj * 128) * 2) = pack8(x0, x1);
                    q += (x0[0] * x0[0] + x0[1] * x0[1]) + (x0[2] * x0[2] + x0[3] * x0[3]) + (x1[0] * x1[0] + x1[1] * x1[1]) + (x1[2] * x1[2] + x1[3] * x1[3]);
                }
                q += __shfl_xor(q, 16); q += __shfl_xor(q, 32);
                if (fq == 0) *WSP(float, SSP_OFF + (unsigned)row * 64u + (unsigned)(u.pn * 4 + wc) * 4u) = q;
            }
    }
};
struct EpiWin {
    static constexpr bool PERM = true, DUAL = false;
    gptr ws;
    __device__ __forceinline__ void operator()(AccRef acc, const Unit& u, int wr, int wc, int fr, int fq) const {
        const int row0 = u.pm * 256 + wr * 64 + fr; const int pn = u.pn;
        float rs[2][4]; rs_rows16(ws, row0, fq, 1.0f / DM, rs);
        if (pn >= 5) {
            DEFBASE(pb, WS_MIX + MX_GA);
            const unsigned gofs = pn <= 8 ? (unsigned)(pn - 5) * 512u : (unsigned)(MX_GB - MX_GA) + (unsigned)(pn - 9) * 512u;
#pragma unroll
            for (int ai = 0; ai < 2; ++ai)
#pragma unroll
                for (int m = 0; m < 4; ++m)
#pragma unroll
                    for (int bj = 0; bj < 2; ++bj) {
                        const int row = row0 + ai * 128 + m * 16; const f32x4 v0 = acc[ai][bj][m][0] * rs[ai][m], v1 = acc[ai][bj][m][1] * rs[ai][m];
                        f32x4 s0, s1;
#pragma unroll
                        for (int j = 0; j < 4; ++j) { s0[j] = sigmoidf_(v0[j]); s1[j] = sigmoidf_(v1[j]); }
                        *AT(u32x4, pb, gofs + (unsigned)row * 2048 + (bj * 128 + wc * 32 + fq * 8) * 2) = pack8(s0, s1);
                    }
        } else if (pn >= 2) {
            DEFBASE(pt, WS_TAB64);
            gptr pb = ws + (pn == 4 ? (size_t)(WS_MIX + MX_GK) : (size_t)(WS_MIX + MX_GQ) + (size_t)(pn - 2) * 512); asm volatile("" : "+s"(pb));
            const unsigned pitch = pn == 4 ? 256u : 1024u; const float qs = pn == 4 ? 1.0f : QS_GQA;
#pragma unroll
            for (int ai = 0; ai < 2; ++ai) {
                f32x4 tb[4][2];
#pragma unroll
                for (int m = 0; m < 4; ++m) { const GAS f32x4* tp = AT(const f32x4, pt, (unsigned)tok_pos(row0 + ai * 128 + m * 16) * 256 + (wc & 1) * 128 + fq * 32); tb[m][0] = tp[0]; tb[m][1] = tp[1]; }
#pragma unroll
                for (int m = 0; m < 4; ++m)
#pragma unroll
                    for (int bj = 0; bj < 2; ++bj) {
                        if (pn == 4 && bj == 1) continue;
                        const int row = row0 + ai * 128 + m * 16; f32x4 v0 = acc[ai][bj][m][0] * rs[ai][m], v1 = acc[ai][bj][m][1] * rs[ai][m];
                        rope8r(v0, v1, tb[m][0], tb[m][1]);
                        *AT(u32x4, pb, (unsigned)row * pitch + (bj * 128 + wc * 32 + fq * 8) * 2) = pack8(v0 * qs, v1 * qs);
                    }
            }
        } else {
            gptr pb = ws + (pn == 0 ? (size_t)(WS_MIX + MX_CQ) : (size_t)(WS_MIX + MX_CKV)); asm volatile("" : "+s"(pb));
            DEFBASE(pt, WS_TAB32);
#pragma unroll
            for (int ai = 0; ai < 2; ++ai)
#pragma unroll
                for (int m = 0; m < 4; ++m) {
                    const int row = row0 + ai * 128 + m * 16; float q0 = 0.f;
#pragma unroll
                    for (int bj = 0; bj < 2; ++bj) {
                        f32x4 v0 = acc[ai][bj][m][0] * rs[ai][m], v1 = acc[ai][bj][m][1] * rs[ai][m];
                        const int lc = bj * 128 + wc * 32 + fq * 8;
                        if (pn == 0 || bj == 0) {
                            q0 += (v0[0] * v0[0] + v0[1] * v0[1]) + (v0[2] * v0[2] + v0[3] * v0[3]) + (v1[0] * v1[0] + v1[1] * v1[1]) + (v1[2] * v1[2] + v1[3] * v1[3]);
                            *AT(u32x4, pb, (unsigned)row * 512 + lc * 2) = pack8(v0, v1);
                        } else if (wc == 0) {
                            const GAS f32x4* tp = AT(const f32x4, pt, (unsigned)tok_pos(row) * 128 + fq * 32);
                            rope8r(v0, v1, tp[0], tp[1]); *AT(u32x4, pb, (unsigned)row * 512 + lc * 2) = pack8(v0, v1);
                        }
                    }
                    q0 += __shfl_xor(q0, 16); q0 += __shfl_xor(q0, 32);
                    if (fq == 0) *WSP(float, (pn == 0 ? SSQP_OFF : SSKVP_OFF) + (unsigned)row * 16u + (unsigned)wc * 4u) = q0;
                }
        }
    }
};
struct EpiQ {
    static constexpr bool PERM = true, DUAL = false;
    gptr ws;
    __device__ __forceinline__ void operator()(AccRef acc, const Unit& u, int wr, int wc, int fr, int fq) const {
        const int row0 = u.pm * 256 + wr * 64 + fr;
        float rs[2][4]; rs_rows4(ws, SSQP_OFF, row0, fq, 1.0f / 256.0f, rs);
#pragma unroll
        for (int bj = 0; bj < 2; ++bj) {
            const int g = u.pn * 8 + bj * 4 + wc, head = g / 3, part = g - head * 3;
            if (part < 2) {
                DEFBASE(pb, WS_MIX + MX_QN);
                const unsigned co = (unsigned)(head * 64 + part * 32 + fq * 8) * 2;
#pragma unroll
                for (int ai = 0; ai < 2; ++ai)
#pragma unroll
                    for (int m = 0; m < 4; ++m) { const int row = row0 + ai * 128 + m * 16; const float r = rs[ai][m] * QS_MLA;
                        *AT(u32x4, pb, (unsigned)row * 1024 + co) = pack8(acc[ai][bj][m][0] * r, acc[ai][bj][m][1] * r); }
            } else {
                DEFBASE(pt, WS_TAB32); DEFBASE(pb, WS_MIX + MX_QP);
                const unsigned co = (unsigned)(head * 32 + fq * 8) * 2;
#pragma unroll
                for (int ai = 0; ai < 2; ++ai) {
                    f32x4 tb[4][2];
#pragma unroll
                    for (int m = 0; m < 4; ++m) { const GAS f32x4* tp = AT(const f32x4, pt, (unsigned)tok_pos(row0 + ai * 128 + m * 16) * 128 + fq * 32); tb[m][0] = tp[0]; tb[m][1] = tp[1]; }
#pragma unroll
                    for (int m = 0; m < 4; ++m) { const int row = row0 + ai * 128 + m * 16; const float r = rs[ai][m] * QS_MLA;
                        f32x4 v0 = acc[ai][bj][m][0] * r, v1 = acc[ai][bj][m][1] * r;
                        rope8r(v0, v1, tb[m][0], tb[m][1]); *AT(u32x4, pb, (unsigned)row * 512 + co) = pack8(v0, v1); }
                }
            }
        }
    }
};
struct EpiKn {
    static constexpr bool PERM = true, DUAL = false;
    gptr ws;
    __device__ __forceinline__ void operator()(AccRef acc, const Unit& u, int wr, int wc, int fr, int fq) const {
        const int row0 = u.pm * 256 + wr * 64 + fr, col0 = u.pn * 256 + wc * 32 + fq * 8;
        float rs[2][4]; rs_rows4(ws, SSKVP_OFF, row0, fq, 1.0f / 128.0f, rs);
        DEFBASE(pb, WS_MIX + MX_KN);
#pragma unroll
        for (int ai = 0; ai < 2; ++ai)
#pragma unroll
            for (int m = 0; m < 4; ++m) {
                const int row = row0 + ai * 128 + m * 16;
#pragma unroll
                for (int bj = 0; bj < 2; ++bj) *AT(u32x4, pb, (unsigned)row * 1024 + (col0 + bj * 128) * 2) = pack8(acc[ai][bj][m][0] * rs[ai][m], acc[ai][bj][m][1] * rs[ai][m]);
            }
    }
};
struct EpiVt {
    static constexpr bool PERM = false, DUAL = false;
    gptr ws; int wide; float invn; unsigned out_off; int nai;
    __device__ __forceinline__ void operator()(AccRef acc, const Unit& u, int wr, int wc, int fr, int fq) const {
        const int vrow0 = u.pm * 256 + wr * 64 + fr, tok0 = u.pn * 256 + wc * 32;
        gptr pb = ws + out_off; asm volatile("" : "+s"(pb));
        float myrs;
        { const int tok = tok0 + (fr >> 3) * 128 + ((fr >> 2) & 1) * 16 + fq * 4 + (fr & 3);
          float s;
          if (wide) { const GAS f32x4* p = (const GAS f32x4*)((ws + SSP_OFF) + (unsigned)(tok * 64)); const f32x4 a = p[0], b = p[1], c = p[2], d = p[3];
                      s = (((a[0] + a[1]) + (a[2] + a[3])) + ((b[0] + b[1]) + (b[2] + b[3]))) + (((c[0] + c[1]) + (c[2] + c[3])) + ((d[0] + d[1]) + (d[2] + d[3]))); }
          else { const f32x4 a = *(const GAS f32x4*)((ws + SSKVP_OFF) + (unsigned)(tok * 16)); s = (a[0] + a[1]) + (a[2] + a[3]); }
          myrs = rstd(s, invn); }
#pragma unroll
        for (int bj = 0; bj < 2; ++bj) {
            f32x4 sc[2];
#pragma unroll
            for (int n = 0; n < 2; ++n)
#pragma unroll
                for (int j = 0; j < 4; ++j) sc[n][j] = __shfl(myrs, fq * 16 + bj * 8 + n * 4 + j);
#pragma unroll
            for (int ai = 0; ai < 2; ++ai) {
                if (ai < nai) {
#pragma unroll
                    for (int m = 0; m < 4; ++m) {
                        const int vrow = vrow0 + ai * 128 + m * 16;
#if ATT32
#pragma unroll
                        for (int n = 0; n < 2; ++n) { const f32x4 v = acc[ai][bj][m][n] * sc[n]; u32x2 w; w.x = cvt_pk_bf16(v[0], v[1]); w.y = cvt_pk_bf16(v[2], v[3]);
                            *AT(u32x2, pb, (unsigned)vrow * (MTOK * 2) + (tok0 + bj * 128 + n * 16 + 8 * (fq & 1) + 4 * (fq >> 1)) * 2) = w; }
#else
                        *AT(u32x4, pb, (unsigned)vrow * (MTOK * 2) + (tok0 + bj * 128 + fq * 8) * 2) = pack8(acc[ai][bj][m][0] * sc[0], acc[ai][bj][m][1] * sc[1]);
#endif
                    }
                }
            }
        }
    }
};
struct EpiGateDual {
    static constexpr bool PERM = true, DUAL = true;
    gptr ws;
    __device__ __forceinline__ void mid(f32x4 (&acc)[2][2][4][2], const Unit& u, int wr, int wc, int fr, int fq) const {
        const int row0 = u.pm * 256 + wr * 64 + fr, col0 = u.pn * 256 + wc * 32 + fq * 8;
        DEFBASE(pa, WS_MIX + MX_GA); DEFBASE(pg, WS_MIX + MX_GB);
#pragma unroll
        for (int ai = 0; ai < 2; ++ai) {
            u32x4 ga[4][2], gb[4][2];
#pragma unroll
            for (int m = 0; m < 4; ++m)
#pragma unroll
                for (int bj = 0; bj < 2; ++bj) { const unsigned eo = (unsigned)(row0 + ai * 128 + m * 16) * 2048 + (col0 + bj * 128) * 2; ga[m][bj] = *AT(const u32x4, pa, eo); gb[m][bj] = *AT(const u32x4, pg, eo); }
#pragma unroll
            for (int m = 0; m < 4; ++m)
#pragma unroll
                for (int bj = 0; bj < 2; ++bj) { f32x4 g0, g1, h0, h1; unpack8(ga[m][bj], g0, g1); unpack8(gb[m][bj], h0, h1);
#pragma unroll
                    for (int j = 0; j < 4; ++j) { acc[ai][bj][m][0][j] *= h0[j] * __builtin_amdgcn_rcpf(fmaxf(g0[j], 1e-30f)); acc[ai][bj][m][1][j] *= h1[j] * __builtin_amdgcn_rcpf(fmaxf(g1[j], 1e-30f)); } }
        }
    }
    __device__ __forceinline__ void operator()(AccRef acc, const Unit& u, int wr, int wc, int fr, int fq) const {
        const int row0 = u.pm * 256 + wr * 64 + fr, col0 = u.pn * 256 + wc * 32 + fq * 8;
        DEFBASE(pa, WS_MIX + MX_GA);
#pragma unroll
        for (int ai = 0; ai < 2; ++ai) {
            u32x4 ga[4][2];
#pragma unroll
            for (int m = 0; m < 4; ++m)
#pragma unroll
                for (int bj = 0; bj < 2; ++bj) ga[m][bj] = *AT(const u32x4, pa, (unsigned)(row0 + ai * 128 + m * 16) * 2048 + (col0 + bj * 128) * 2);
#pragma unroll
            for (int m = 0; m < 4; ++m)
#pragma unroll
                for (int bj = 0; bj < 2; ++bj) { f32x4 g0, g1; unpack8(ga[m][bj], g0, g1);
#pragma unroll
                    for (int j = 0; j < 4; ++j) { g0[j] = fmaxf(g0[j], 1e-30f) * acc[ai][bj][m][0][j]; g1[j] = fmaxf(g1[j], 1e-30f) * acc[ai][bj][m][1][j]; }
                    *AT(u32x4, pa, (unsigned)(row0 + ai * 128 + m * 16) * 2048 + (col0 + bj * 128) * 2) = pack8(g0, g1); }
        }
    }
};
template <int MODE> struct EpiGate {
    static constexpr bool PERM = true, DUAL = false;
    gptr ws;
    __device__ __forceinline__ void operator()(AccRef acc, const Unit& u, int wr, int wc, int fr, int fq) const {
        const int row0 = u.pm * 256 + wr * 64 + fr, col0 = u.pn * 256 + wc * 32 + fq * 8;
        DEFBASE(pa, WS_MIX + MX_GA); DEFBASE(pt, WS_MIX + MX_KN); DEFBASE(pg, WS_MIX + MX_GB);
#pragma unroll
        for (int ai = 0; ai < 2; ++ai) {
            u32x4 ga[4][2], gb[4][2];
#pragma unroll
            for (int m = 0; m < 4; ++m)
#pragma unroll
                for (int bj = 0; bj < 2; ++bj) { const unsigned eo = (unsigned)(row0 + ai * 128 + m * 16) * 2048 + (col0 + bj * 128) * 2;
                    ga[m][bj] = *AT(const u32x4, MODE == 0 ? pa : pt, eo); if (MODE == 1) gb[m][bj] = *AT(const u32x4, pg, eo); }
#pragma unroll
            for (int m = 0; m < 4; ++m)
#pragma unroll
                for (int bj = 0; bj < 2; ++bj) { const unsigned eo = (unsigned)(row0 + ai * 128 + m * 16) * 2048 + (col0 + bj * 128) * 2;
                    f32x4 g0, g1; unpack8(ga[m][bj], g0, g1);
                    if (MODE == 0) { g0 = g0 * acc[ai][bj][m][0]; g1 = g1 * acc[ai][bj][m][1]; *AT(u32x4, pt, eo) = pack8(g0, g1); }
                    else { f32x4 h0, h1; unpack8(gb[m][bj], h0, h1); g0 = g0 + h0 * acc[ai][bj][m][0]; g1 = g1 + h1 * acc[ai][bj][m][1]; *AT(u32x4, pa, eo) = pack8(g0, g1); } }
        }
    }
};

#if ATT32
#define ATTN_FN attn_unit32
#else
#define ATTN_FN attn_unit
#endif
__device__ __forceinline__ float max3_asm(float a, float b, float c) { float r; asm("v_max3_f32 %0, %1, %2, %3" : "=v"(r) : "v"(a), "v"(b), "v"(c)); return r; }
constexpr int ATT_BUF = 20480;
template <int NDS, bool GQA>
__device__ __forceinline__ void attn_unit(LAS unsigned char* lds, gptr ws,
        unsigned qa_off, unsigned ldqa, unsigned qb_off, unsigned ldqb,
        int qrow,
        unsigned k0_off, unsigned ldk0, unsigned k1_off, unsigned ldk1,
        unsigned vt_off,
        int kv_lo, int kv_hi,
        float sinkl, unsigned o_off) {
    constexpr float THR = 8.0f;
    int tid = threadIdx.x; asm volatile("" : "+v"(tid));
    const int lane = tid & 63, fr = lane & 15, fq = lane >> 4;
    const int foff = (fr * 64 + fq * 16) ^ ((fr >> 3) << 5);
    constexpr int NPC = 4 * NDS + 8, PPW = (2 * NPC) / 8;
    constexpr int ATT_CH = 2 * ATT_BUF;
    const int wv = __builtin_amdgcn_readfirstlane(tid >> 6);
    unsigned gsrc[PPW]; int pdst[PPW]; unsigned pstr[PPW];
    {
        const int obp = lane * 16, ob = obp ^ (((obp >> 9) & 1) << 5), rr = ob >> 6, cc = (ob & 63) >> 4;
#pragma unroll
        for (int j = 0; j < PPW; ++j) {
            const int pc = wv + 8 * j, tt = pc / NPC, p = pc - tt * NPC;
            if (p < 4 * NDS) { const int kb = p / NDS, ds = p - kb * NDS, row = 64 * tt + 16 * kb + rr;
                if (NDS == 3 && ds == 2) { gsrc[j] = k1_off + (unsigned)(kv_lo + row) * ldk1 + cc * 16; pstr[j] = 128 * ldk1; }
                else { gsrc[j] = k0_off + (unsigned)(kv_lo + row) * ldk0 + ds * 64 + cc * 16; pstr[j] = 128 * ldk0; }
                pdst[j] = tt * ATT_BUF + p * 1024;
            } else { const int v = p - 4 * NDS, db = v >> 1, sl = v & 1;
                gsrc[j] = vt_off + (unsigned)(16 * db + rr) * (MTOK * 2) + (unsigned)(kv_lo + 64 * tt) * 2 + (sl * 4 + cc) * 16; pstr[j] = 256;
                pdst[j] = tt * ATT_BUF + 12288 + v * 1024; }
        }
    }
    bf16x8 qf[2][NDS];
#pragma unroll
    for (int qb = 0; qb < 2; ++qb) {
#pragma unroll
        for (int ds = 0; ds < 2; ++ds) qf[qb][ds] = *WSP(const bf16x8, qa_off + (unsigned)(qb * 16 + fr) * ldqa + ds * 64 + fq * 16);
        if (NDS == 3) qf[qb][NDS - 1] = *WSP(const bf16x8, qb_off + (unsigned)(qb * 16 + fr) * ldqb + fq * 16);
    }
    f32x4 o[4][2];
#pragma unroll
    for (int db = 0; db < 4; ++db) { o[db][0] = (f32x4){0.f, 0.f, 0.f, 0.f}; o[db][1] = (f32x4){0.f, 0.f, 0.f, 0.f}; }
    float NEG = -1e30f; asm volatile("" : "+s"(NEG));
    float mref[2];
    const int nt = (kv_hi - kv_lo) >> 6;
#define ATT_DMA(b) do { _Pragma("unroll") for (int j_ = 0; j_ < PPW; ++j_) { \
        __builtin_amdgcn_global_load_lds((const GAS unsigned*)(ws + gsrc[j_]), (LAS unsigned*)(lds + (b) * ATT_CH + pdst[j_]), 16, 0, 0); gsrc[j_] += pstr[j_]; } } while (0)
#define ATT_WAITBAR(N) asm volatile("s_waitcnt vmcnt(" #N ") lgkmcnt(0)\n\ts_barrier" ::: "memory")
#define ATT_QK(S, bufp, c0, c1) do { \
        _Pragma("unroll") for (int kb = 0; kb < 4; ++kb) { S[kb][0] = (f32x4){c0, c0, c0, c0}; S[kb][1] = (f32x4){c1, c1, c1, c1}; } \
        bf16x8 kf_[NDS][4]; \
        _Pragma("unroll") for (int ds = 0; ds < NDS; ++ds) _Pragma("unroll") for (int kb = 0; kb < 4; ++kb) kf_[ds][kb] = *(const LAS bf16x8*)((bufp) + (kb * NDS + ds) * 1024 + foff); \
        __builtin_amdgcn_sched_barrier(0); \
        _Pragma("unroll") for (int ds = 0; ds < NDS; ++ds) _Pragma("unroll") for (int kb = 0; kb < 4; ++kb) { \
            S[kb][0] = __builtin_amdgcn_mfma_f32_16x16x32_bf16(kf_[ds][kb], qf[0][ds], S[kb][0], 0, 0, 0); \
            S[kb][1] = __builtin_amdgcn_mfma_f32_16x16x32_bf16(kf_[ds][kb], qf[1][ds], S[kb][1], 0, 0, 0); } } while (0)
#define ATT_QKN(S, bufp) do { \
        bf16x8 kf_[NDS][4]; \
        _Pragma("unroll") for (int ds = 0; ds < NDS; ++ds) _Pragma("unroll") for (int kb = 0; kb < 4; ++kb) kf_[ds][kb] = *(const LAS bf16x8*)((bufp) + (kb * NDS + ds) * 1024 + foff); \
        __builtin_amdgcn_sched_barrier(0); \
        _Pragma("unroll") for (int ds = 0; ds < NDS; ++ds) _Pragma("unroll") for (int kb = 0; kb < 4; ++kb) { \
            S[kb][0] = __builtin_amdgcn_mfma_f32_16x16x32_bf16(kf_[ds][kb], qf[0][ds], ds == 0 ? negm0 : S[kb][0], 0, 0, 0); \
            S[kb][1] = __builtin_amdgcn_mfma_f32_16x16x32_bf16(kf_[ds][kb], qf[1][ds], ds == 0 ? negm1 : S[kb][1], 0, 0, 0); } } while (0)
#define ATT_MASK(S, kv0) do { if (GQA) { _Pragma("unroll") for (int qb = 0; qb < 2; ++qb) { const int qp = qrow + qb * 16 + fr; \
        _Pragma("unroll") for (int kb = 0; kb < 4; ++kb) _Pragma("unroll") for (int j = 0; j < 4; ++j) { const int d = qp - ((kv0) + kb * 16 + fq * 4 + j); if (d > 128 || d < -128) S[kb][qb][j] = NEG; } } } } while (0)
#define MX3(a, b, c) __builtin_fmaxf(__builtin_fmaxf((a), (b)), (c))
#define ATT_LMAX(S, qb) __builtin_fmaxf(MX3(MX3(MX3(S[0][qb][0], S[0][qb][1], S[0][qb][2]), S[0][qb][3], S[1][qb][0]), S[1][qb][1], S[1][qb][2]), \
                                        MX3(MX3(MX3(MX3(S[1][qb][3], S[2][qb][0], S[2][qb][1]), S[2][qb][2], S[2][qb][3]), S[3][qb][0], S[3][qb][1]), S[3][qb][2], S[3][qb][3]))
#define MX3A(a, b, c) max3_asm((a), (b), (c))
#define ATT_LMAXA(S, qb) MX3A(MX3A(MX3A(MX3A(S[0][qb][0], S[0][qb][1], S[0][qb][2]), S[0][qb][3], S[1][qb][0]), S[1][qb][1], S[1][qb][2]), S[1][qb][3], \
                              MX3A(MX3A(MX3A(MX3A(S[2][qb][0], S[2][qb][1], S[2][qb][2]), S[2][qb][3], S[3][qb][0]), S[3][qb][1], S[3][qb][2]), S[3][qb][3], S[3][qb][3]))
    ATT_DMA(0); ATT_DMA(1);
    ATT_WAITBAR(0);
    f32x4 sA[4][2], sB[4][2];
    ATT_QK(sA, lds, 0.f, 0.f);
    ATT_MASK(sA, kv_lo);
#pragma unroll
    for (int qb = 0; qb < 2; ++qb) {
        float mx = ATT_LMAX(sA, qb);
        mx = fmaxf(mx, __shfl_xor(mx, 16)); mx = fmaxf(mx, __shfl_xor(mx, 32));
        mref[qb] = (mx < -1e29f) ? 0.f : mx;
#pragma unroll
        for (int kb = 0; kb < 4; ++kb) sA[kb][qb] = sA[kb][qb] - mref[qb];
    }
    f32x4 negm0 = {-mref[0], -mref[0], -mref[0], -mref[0]}, negm1 = {-mref[1], -mref[1], -mref[1], -mref[1]};
    const short one_bf = (fr == 0) ? (short)0x3F80 : (short)0;
    const bf16x8 onesf = {one_bf, one_bf, one_bf, one_bf, one_bf, one_bf, one_bf, one_bf};
    f32x4 lacc[2] = {(f32x4){0.f, 0.f, 0.f, 0.f}, (f32x4){0.f, 0.f, 0.f, 0.f}};
    int cb = 0;
#define ATT_STEP(SC, SN, t, has1, ODD, BAR, ISSUE) do { \
        if (BAR) ATT_WAITBAR(0); \
        LAS unsigned char* bufc = lds + cb * ATT_CH + (ODD ? ATT_BUF : 0); \
        const int cbn = (cb == 2) ? 0 : cb + 1; \
        if (ISSUE) ATT_DMA((cb == 0) ? 2 : cb - 1); \
        if (has1) ATT_QKN(SN, (ODD ? lds + cbn * ATT_CH : lds + cb * ATT_CH + ATT_BUF)); \
        bf16x8 pf[2][2]; \
        _Pragma("unroll") for (int qb = 0; qb < 2; ++qb) { \
            _Pragma("unroll") for (int kb = 0; kb < 4; ++kb) _Pragma("unroll") for (int j = 0; j < 4; ++j) SC[kb][qb][j] = __builtin_amdgcn_exp2f(SC[kb][qb][j]); \
            _Pragma("unroll") for (int sl = 0; sl < 2; ++sl) pf[qb][sl] = __builtin_bit_cast(bf16x8, pack8(SC[2 * sl][qb], SC[2 * sl + 1][qb])); } \
        if (has1) ATT_MASK(SN, kv_lo + ((t) + 1) * 64); \
        bf16x8 vf_[2][4]; \
        _Pragma("unroll") for (int sl = 0; sl < 2; ++sl) _Pragma("unroll") for (int db = 0; db < 4; ++db) vf_[sl][db] = *(const LAS bf16x8*)(bufc + 12288 + (db * 2 + sl) * 1024 + foff); \
        _Pragma("unroll") for (int sl = 0; sl < 2; ++sl) { \
            _Pragma("unroll") for (int db = 0; db < 4; ++db) { \
                o[db][0] = __builtin_amdgcn_mfma_f32_16x16x32_bf16(vf_[sl][db], pf[0][sl], o[db][0], 0, 0, 0); \
                o[db][1] = __builtin_amdgcn_mfma_f32_16x16x32_bf16(vf_[sl][db], pf[1][sl], o[db][1], 0, 0, 0); } \
            lacc[0] = __builtin_amdgcn_mfma_f32_16x16x32_bf16(onesf, pf[0][sl], lacc[0], 0, 0, 0); \
            lacc[1] = __builtin_amdgcn_mfma_f32_16x16x32_bf16(onesf, pf[1][sl], lacc[1], 0, 0, 0); } \
        if (has1) { \
            const float l0 = ATT_LMAXA(SN, 0), l1 = ATT_LMAXA(SN, 1);     \
            if (__builtin_expect(__any((l0 > THR) || (l1 > THR)), 0)) { \
                _Pragma("unroll") for (int qb = 0; qb < 2; ++qb) { \
                    float mx = qb == 0 ? l0 : l1; \
                    mx = fmaxf(mx, __shfl_xor(mx, 16)); mx = fmaxf(mx, __shfl_xor(mx, 32)); \
                    const float dl = fmaxf(mx, 0.f), f = __builtin_amdgcn_exp2f(-dl); \
                    mref[qb] += dl; lacc[qb] = lacc[qb] * f; if (qb == 0) negm0 = negm0 - dl; else negm1 = negm1 - dl; \
                    _Pragma("unroll") for (int kb = 0; kb < 4; ++kb) SN[kb][qb] = SN[kb][qb] - dl; \
                    _Pragma("unroll") for (int db = 0; db < 4; ++db) o[db][qb] = o[db][qb] * f; } } } \
        if (ODD) cb = cbn; } while (0)
    int t = 0;
    for (; t + 4 < nt; t += 2) {
        ATT_STEP(sA, sB, t, true, false, false, false);
        ATT_STEP(sB, sA, t + 1, true, true, true, true);
    }
    ATT_STEP(sA, sB, t, true, false, false, false);
    ATT_STEP(sB, sA, t + 1, true, true, true, false);
    ATT_STEP(sA, sB, t + 2, true, false, false, false);
    ATT_STEP(sB, sA, t + 3, false, true, false, false);
    ATT_WAITBAR(0);
#undef ATT_STEP
#undef ATT_DMA
#undef ATT_WAITBAR
#undef ATT_QK
#undef ATT_QKN
#undef ATT_MASK
#undef ATT_LMAX
#undef ATT_LMAXA
#undef MX3A
#undef MX3
#pragma unroll
    for (int qb = 0; qb < 2; ++qb) {
        float l = __shfl(lacc[qb][0], fr);
        if (GQA) l += __builtin_amdgcn_exp2f(sinkl - mref[qb]);
        const float rl = 1.0f / l;
#pragma unroll
        for (int db = 0; db < 4; ++db) { const f32x4 v = o[db][qb] * rl; u32x2 w; w.x = cvt_pk_bf16(v[0], v[1]); w.y = cvt_pk_bf16(v[2], v[3]);
            *WSP(u32x2, o_off + (unsigned)(qb * 16 + fr) * ldqa + db * 32 + fq * 8) = w; }
    }
}


typedef float f32x16 __attribute__((ext_vector_type(16)));
template <int NDS, bool GQA>
__device__ __forceinline__ void attn_unit32(LAS unsigned char* lds, gptr ws,
        unsigned qa_off, unsigned ldqa, unsigned qb_off, unsigned ldqb, int qrow,
        unsigned k0_off, unsigned ldk0, unsigned k1_off, unsigned ldk1, unsigned vt_off,
        int kv_lo, int kv_hi, float sinkl, unsigned o_off) {
    constexpr float THR = 8.0f;
    constexpr int NSL = 2 * NDS;
    int tid = threadIdx.x; asm volatile("" : "+v"(tid));
    const int lane = tid & 63, r32 = lane & 31, hi = lane >> 5;
    const int sw = (r32 >> 2) & 3;
    const int foffE = r32 * 64 + ((hi ^ sw) << 4), foffO = r32 * 64 + (((2 + hi) ^ sw) << 4);
    constexpr int NPC = 4 * NDS + 8, PPW = (NPC + 7) / 8;
    const int wv = __builtin_amdgcn_readfirstlane(tid >> 6);
    unsigned gsrc[PPW]; int pdst[PPW]; unsigned pstr[PPW];
#pragma unroll
    for (int j = 0; j < PPW; ++j) {
        int p = wv + 8 * j; if (p >= NPC) p -= 8;
        if (p < 4 * NDS) { const int s = p >> 1, h = p & 1, kb = s / NDS, dp = s - kb * NDS, r = 16 * h + (lane >> 2), c = (lane & 3) ^ ((r >> 2) & 3), row = 32 * kb + r;
            if (NDS == 3 && dp == 2) { gsrc[j] = k1_off + (unsigned)(kv_lo + row) * ldk1 + c * 16; pstr[j] = 64 * ldk1; }
            else { gsrc[j] = k0_off + (unsigned)(kv_lo + row) * ldk0 + dp * 64 + c * 16; pstr[j] = 64 * ldk0; }
            pdst[j] = p * 1024;
        } else { const int v = p - 4 * NDS, s = v >> 1, h = v & 1, db = s >> 1, sp = s & 1, r = 16 * h + (lane >> 2), c = (lane & 3) ^ ((r >> 2) & 3);
            gsrc[j] = vt_off + (unsigned)(32 * db + r) * (MTOK * 2) + (unsigned)kv_lo * 2 + (sp * 4 + c) * 16; pstr[j] = 128;
            pdst[j] = 12288 + v * 1024; }
    }
    bf16x8 qf[NSL];
#pragma unroll
    for (int ds = 0; ds < NSL; ++ds) {
        if (ds < 4) qf[ds] = *WSP(const bf16x8, qa_off + (unsigned)r32 * ldqa + (16 * ds + 8 * hi) * 2);
        else qf[ds] = *WSP(const bf16x8, qb_off + (unsigned)r32 * ldqb + (16 * (ds - 4) + 8 * hi) * 2);
    }
    f32x16 o[2];
#pragma unroll
    for (int i = 0; i < 16; ++i) { o[0][i] = 0.f; o[1][i] = 0.f; }
    float NEG = -1e30f; asm volatile("" : "+s"(NEG));
    float mref;
    const int nt = (kv_hi - kv_lo) >> 6;
#define ATT_DMA(b) do { _Pragma("unroll") for (int j_ = 0; j_ < PPW; ++j_) { \
        __builtin_amdgcn_global_load_lds((const GAS unsigned*)(ws + gsrc[j_]), (LAS unsigned*)(lds + (b) * ATT_BUF + pdst[j_]), 16, 0, 0); gsrc[j_] += pstr[j_]; } } while (0)
#define ATT_WAITBAR(N) asm volatile("s_waitcnt vmcnt(" #N ") lgkmcnt(0)\n\ts_barrier" ::: "memory")
#define ATT_QK(S, bufp, CI) do { \
        bf16x8 kf_[2][NSL]; \
        _Pragma("unroll") for (int kb = 0; kb < 2; ++kb) _Pragma("unroll") for (int ds = 0; ds < NSL; ++ds) kf_[kb][ds] = *(const LAS bf16x8*)((bufp) + (kb * NDS + (ds >> 1)) * 2048 + ((ds & 1) ? foffO : foffE)); \
        __builtin_amdgcn_sched_barrier(0); \
        _Pragma("unroll") for (int ds = 0; ds < NSL; ++ds) _Pragma("unroll") for (int kb = 0; kb < 2; ++kb) \
            S[kb] = __builtin_amdgcn_mfma_f32_32x32x16_bf16(kf_[kb][ds], qf[ds], ds == 0 ? CI : S[kb], 0, 0, 0); } while (0)
#define ATT_MASK(S, kv0) do { if (GQA) { const int qp = qrow + r32; \
        _Pragma("unroll") for (int kb = 0; kb < 2; ++kb) _Pragma("unroll") for (int r = 0; r < 16; ++r) { const int d = qp - ((kv0) + kb * 32 + (r & 3) + 8 * (r >> 2) + 4 * hi); if (d > 128 || d < -128) S[kb][r] = NEG; } } } while (0)
#define MX3(a, b, c) __builtin_fmaxf(__builtin_fmaxf((a), (b)), (c))
#define ATT_LMAX16(V) MX3(MX3(MX3(MX3(MX3(MX3(MX3(V[0], V[1], V[2]), V[3], V[4]), V[5], V[6]), V[7], V[8]), V[9], V[10]), V[11], V[12]), V[13], V[14])
#define ATT_LMAX(S) __builtin_fmaxf(__builtin_fmaxf(ATT_LMAX16(S[0]), S[0][15]), __builtin_fmaxf(ATT_LMAX16(S[1]), S[1][15]))
    ATT_DMA(0); ATT_DMA(1); ATT_DMA(2);
    ATT_WAITBAR(0);
    f32x16 sA[2], sB[2], negm;
#pragma unroll
    for (int i = 0; i < 16; ++i) negm[i] = 0.f;
    ATT_QK(sA, lds, negm);
    ATT_MASK(sA, kv_lo);
    {
        float mx = ATT_LMAX(sA);
        mx = fmaxf(mx, __shfl_xor(mx, 32));
        mref = (mx < -1e29f) ? 0.f : mx;
#pragma unroll
        for (int i = 0; i < 16; ++i) { sA[0][i] -= mref; sA[1][i] -= mref; negm[i] = -mref; }
    }
    const short one_bf = (r32 == 0) ? (short)0x3F80 : (short)0;
    const bf16x8 onesf = {one_bf, one_bf, one_bf, one_bf, one_bf, one_bf, one_bf, one_bf};
    f32x16 lacc;
#pragma unroll
    for (int i = 0; i < 16; ++i) lacc[i] = 0.f;
    int bcur = 0;
#define ATT_STEP(SC, SN, t, has1, ISSUE, WN) do { \
        if (WN) { if (PPW == 3) ATT_WAITBAR(3); else ATT_WAITBAR(2); } else ATT_WAITBAR(0); \
        LAS unsigned char* bufc = lds + bcur * ATT_BUF; \
        if (ISSUE) ATT_DMA((bcur + 3) & 3); \
        if (has1) ATT_QK(SN, lds + ((bcur + 1) & 3) * ATT_BUF, negm); \
        bf16x8 pf[4]; \
        _Pragma("unroll") for (int kb = 0; kb < 2; ++kb) { \
            _Pragma("unroll") for (int r = 0; r < 16; ++r) SC[kb][r] = __builtin_amdgcn_exp2f(SC[kb][r]); \
            _Pragma("unroll") for (int h = 0; h < 2; ++h) { u32x4 w_; w_.x = cvt_pk_bf16(SC[kb][8 * h + 0], SC[kb][8 * h + 1]); w_.y = cvt_pk_bf16(SC[kb][8 * h + 2], SC[kb][8 * h + 3]); \
                w_.z = cvt_pk_bf16(SC[kb][8 * h + 4], SC[kb][8 * h + 5]); w_.w = cvt_pk_bf16(SC[kb][8 * h + 6], SC[kb][8 * h + 7]); pf[2 * kb + h] = __builtin_bit_cast(bf16x8, w_); } } \
        if (has1) ATT_MASK(SN, kv_lo + ((t) + 1) * 64); \
        bf16x8 vf_[2][4]; \
        _Pragma("unroll") for (int db = 0; db < 2; ++db) _Pragma("unroll") for (int sl = 0; sl < 4; ++sl) vf_[db][sl] = *(const LAS bf16x8*)(bufc + 12288 + (db * 2 + (sl >> 1)) * 2048 + ((sl & 1) ? foffO : foffE)); \
        _Pragma("unroll") for (int sl = 0; sl < 4; ++sl) { \
            o[0] = __builtin_amdgcn_mfma_f32_32x32x16_bf16(vf_[0][sl], pf[sl], o[0], 0, 0, 0); \
            o[1] = __builtin_amdgcn_mfma_f32_32x32x16_bf16(vf_[1][sl], pf[sl], o[1], 0, 0, 0); \
            lacc = __builtin_amdgcn_mfma_f32_32x32x16_bf16(onesf, pf[sl], lacc, 0, 0, 0); } \
        if (has1) { \
            const float l0 = ATT_LMAX(SN); \
            if (__builtin_expect(__any(l0 > THR), 0)) { \
                float mx = fmaxf(l0, __shfl_xor(l0, 32)); \
                const float dl = fmaxf(mx, 0.f), f = __builtin_amdgcn_exp2f(-dl); \
                mref += dl; \
                _Pragma("unroll") for (int i = 0; i < 16; ++i) { SN[0][i] -= dl; SN[1][i] -= dl; o[0][i] *= f; o[1][i] *= f; lacc[i] *= f; negm[i] = -mref; } } } \
        bcur = (bcur + 1) & 3; } while (0)
    int t = 0;
    for (; t + 4 < nt; t += 2) {
        ATT_STEP(sA, sB, t, true, true, 1);
        ATT_STEP(sB, sA, t + 1, true, true, 1);
    }
    ATT_STEP(sA, sB, t, true, true, 1);
    ATT_STEP(sB, sA, t + 1, true, false, 1);
    ATT_STEP(sA, sB, t + 2, true, false, 0);
    ATT_STEP(sB, sA, t + 3, false, false, 0);
    ATT_WAITBAR(0);
#undef ATT_STEP
#undef ATT_DMA
#undef ATT_WAITBAR
#undef ATT_QK
#undef ATT_MASK
#undef ATT_LMAX
#undef ATT_LMAX16
#undef MX3
    {
        float l = __shfl(lacc[0], r32);
        if (GQA) l += __builtin_amdgcn_exp2f(sinkl - mref);
        const float rl = 1.0f / l;
#pragma unroll
        for (int db = 0; db < 2; ++db)
#pragma unroll
            for (int g = 0; g < 4; ++g) { u32x2 w; w.x = cvt_pk_bf16(o[db][4 * g] * rl, o[db][4 * g + 1] * rl); w.y = cvt_pk_bf16(o[db][4 * g + 2] * rl, o[db][4 * g + 3] * rl);
                *WSP(u32x2, o_off + (unsigned)r32 * ldqa + (32 * db + 8 * g + 4 * hi) * 2) = w; }
    }
}

struct Args { const float* in[21]; float* out; unsigned char* ws; int ph_lo, ph_hi; };
__device__ __forceinline__ const GAS float* inptr(int i) {
    asm volatile("" : "+s"(i));
    const __attribute__((address_space(4))) unsigned long long* ka = (const __attribute__((address_space(4))) unsigned long long*)__builtin_amdgcn_kernarg_segment_ptr();
    return (const GAS float*)ka[i];
}
__device__ __forceinline__ int prep_col(int kind, int n, int& alt) {
    alt = 0;
    switch (kind) {
    case 0: return n;
    case 1: { const int pn = n >> 8, jj = n & 255; alt = jj >> 7; return 128 * pn + (jj & 127); }
    case 2: {
        if (n < 384) return n;
        if (n < 416) { const int r = n - 384; return 384 + (r >> 1) + ((r & 1) ? 16 : 0); }
        if (n < 512) return -1;
        if (n < 1024) { const int r = n - 512, h = r >> 6, e = r & 63; return 416 + 64 * h + (e >> 1) + ((e & 1) ? 32 : 0); }
        if (n < 1152) { const int r = n - 1024, h = r >> 6, e = r & 63; return 928 + 64 * h + (e >> 1) + ((e & 1) ? 32 : 0); }
        if (n < 1280) return -1;
        return 1184 + (n - 1280); }
    case 3: return n < 128 ? 1056 + n : -1;
    case 4: { const int h = n / 96, e = n - h * 96; if (e < 64) return 96 * h + e; const int r = e - 64; return 96 * h + 64 + (r >> 1) + ((r & 1) ? 16 : 0); }
    case 5: { const int h = n >> 6, e = n & 63; return 128 * h + e; }
    default: { const int h = n >> 6, e = n & 63; return 128 * h + 64 + e; }
    }
}
template <int KIND>
__device__ __forceinline__ void prep_matrix(const GAS float* s0, const GAS float* s1, const GAS float* gain, gptr ws, unsigned dst_off, int K, int pitch, int Nout, LAS float* scr, int gw, int ngw, int lane, int& rot) {
    asm volatile("" : "+s"(dst_off));
    const int nblk = Nout / 32, nitems = (K / 64) * nblk;
    const int first = (gw + ngw - (rot % ngw)) % ngw; rot += nitems;
    for (int it = first; it < nitems; it += ngw) {
        const int kb = it / nblk, nb = it - kb * nblk, k0 = 64 * kb, n0 = 32 * nb;
        int alt; const int col = prep_col(KIND, n0 + (lane & 31), alt);
        const GAS float* sp = (KIND == 1 && alt) ? s1 : s0;
        float vals[32];
        const GAS float* spk = sp + (size_t)(k0 + (lane >> 5)) * pitch + (col >= 0 ? col : 0);
#pragma unroll
        for (int i = 0; i < 32; ++i) vals[i] = spk[(size_t)(2 * i) * pitch];
        const float g0 = gain ? 0.f : 1.f;
#pragma unroll
        for (int i = 0; i < 32; ++i) { const int kk = 2 * i + (lane >> 5); float v = vals[i] * (gain ? gain[k0 + kk] : 1.0f); if (col < 0) v = g0 * 0.f; scr[kk * 33 + (lane & 31)] = v; }
        asm volatile("s_waitcnt lgkmcnt(0)" ::: "memory");
        const int c = lane & 7;
#pragma unroll
        for (int q = 0; q < 4; ++q) { const int n = (lane >> 3) + 8 * q; const LAS float* s = scr + (8 * c) * 33 + n;
            u32x4 o; o.x = cvt_pk_bf16(s[0 * 33], s[1 * 33]); o.y = cvt_pk_bf16(s[2 * 33], s[3 * 33]); o.z = cvt_pk_bf16(s[4 * 33], s[5 * 33]); o.w = cvt_pk_bf16(s[6 * 33], s[7 * 33]);
            *WSP(u32x4, dst_off + ((unsigned)(n0 + n) * K + k0 + 8 * c) * 2) = o; }
        asm volatile("s_waitcnt lgkmcnt(0)" ::: "memory");
    }
}

__device__ __forceinline__ void prep_layer(gptr ws, int l, LAS float* scr, int gw, int ngw, int lane, int half, int& rot) {
    const size_t oF = (size_t)l * DM * FF, oD = (size_t)l * DM;
    if (half & 1) {
        prep_matrix<1>(inptr(3) + oF, inptr(4) + oF, inptr(2) + oD, ws, WS_W + W_13A, DM, FF, 2 * FF, scr, gw, ngw, lane, rot);
        prep_matrix<0>(inptr(5) + oF, nullptr, nullptr, ws, WS_W + W_2A, FF, DM, DM, scr, gw, ngw, lane, rot);
        prep_matrix<2>(inptr(7) + (size_t)l * DM * 3232, nullptr, inptr(6) + oD, ws, WS_W + W_IN, DM, 3232, 3328, scr, gw, ngw, lane, rot);
        prep_matrix<3>(inptr(7) + (size_t)l * DM * 3232, nullptr, inptr(6) + oD, ws, WS_W + W_GVA, DM, 3232, 256, scr, gw, ngw, lane, rot);
        prep_matrix<4>(inptr(10) + (size_t)l * 256 * 768, nullptr, inptr(8) + (size_t)l * 256, ws, WS_W + W_UQ, 256, 768, 768, scr, gw, ngw, lane, rot);
        prep_matrix<5>(inptr(11) + (size_t)l * 128 * 1024, nullptr, inptr(9) + (size_t)l * 128, ws, WS_W + W_KN, 128, 1024, 512, scr, gw, ngw, lane, rot);
        prep_matrix<6>(inptr(11) + (size_t)l * 128 * 1024, nullptr, inptr(9) + (size_t)l * 128, ws, WS_W + W_VT, 128, 1024, 512, scr, gw, ngw, lane, rot);
    }
    if (half & 2) {
        prep_matrix<1>(inptr(17) + oF, inptr(18) + oF, inptr(16) + oD, ws, WS_W + W_13B, DM, FF, 2 * FF, scr, gw, ngw, lane, rot);
        prep_matrix<0>(inptr(19) + oF, nullptr, nullptr, ws, WS_W + W_2B, FF, DM, DM, scr, gw, ngw, lane, rot);
        prep_matrix<0>(inptr(12) + (size_t)l * 512 * 1024, nullptr, nullptr, ws, WS_W + W_OA, 512, 1024, 1024, scr, gw, ngw, lane, rot);
        prep_matrix<0>(inptr(14) + (size_t)l * 512 * 1024, nullptr, nullptr, ws, WS_W + W_OB, 512, 1024, 1024, scr, gw, ngw, lane, rot);
        prep_matrix<0>(inptr(15) + (size_t)l * 1024 * 1024, nullptr, nullptr, ws, WS_W + W_OUT, 1024, 1024, 1024, scr, gw, ngw, lane, rot);
    }
}

__device__ __forceinline__ float wave_sum(float v) {
#pragma unroll
    for (int o = 1; o < 64; o <<= 1) v += __shfl_xor(v, o);
    return v;
}

__device__ const float ROPE_FREQ[48] = {1.000000000e+00f, 5.623413324e-01f, 3.162277639e-01f, 1.778279394e-01f, 1.000000015e-01f, 5.623413250e-02f, 3.162277490e-02f, 1.778279431e-02f, 9.999999776e-03f, 5.623413250e-03f, 3.162277630e-03f, 1.778279431e-03f, 1.000000047e-03f, 5.623413017e-04f, 3.162277571e-04f, 1.778279402e-04f, 1.000000000e+00f, 7.498942614e-01f, 5.623413324e-01f, 4.216965139e-01f, 3.162277639e-01f, 2.371373773e-01f, 1.778279394e-01f, 1.333521307e-01f, 1.000000015e-01f, 7.498941571e-02f, 5.623413250e-02f, 4.216965288e-02f, 3.162277490e-02f, 2.371373773e-02f, 1.778279431e-02f, 1.333521493e-02f, 9.999999776e-03f, 7.498941850e-03f, 5.623413250e-03f, 4.216964822e-03f, 3.162277630e-03f, 2.371373586e-03f, 1.778279431e-03f, 1.333521446e-03f, 1.000000047e-03f, 7.498942432e-04f, 5.623413017e-04f, 4.216965172e-04f, 3.162277571e-04f, 2.371373703e-04f, 1.778279402e-04f, 1.333521504e-04f};

#define XB_TMO      128
#define XB_XCNT(j)  (256  + 64 * (j))
#define XB_XSUB(j)  (1280 + 64 * (j))
#define XB_XGEN(j)  (2304 + 64 * (j))
#define XB_TOP      3328
#define XB_TOPGEN   3392
#define XCD_BAR_WORDS 3456
#define XB_SPIN_CAP (1u << 22)
__device__ __forceinline__ unsigned xb_ld(unsigned* p)              { return __hip_atomic_load(p, __ATOMIC_RELAXED, __HIP_MEMORY_SCOPE_AGENT); }
__device__ __forceinline__ unsigned xb_add(unsigned* p, unsigned v) { return __hip_atomic_fetch_add(p, v, __ATOMIC_RELAXED, __HIP_MEMORY_SCOPE_AGENT); }
__device__ __forceinline__ unsigned xb_xcc_id() { return (unsigned)__builtin_amdgcn_s_getreg((3 << 11) | 20) & 0xFu; }
#define XB_SPIN(cond, bar) do { unsigned _sp = 0; while (cond) { __builtin_amdgcn_s_sleep(1); \
    if ((++_sp & 255u) == 0u) { if (xb_ld(&(bar)[XB_TMO])) break; if (_sp > XB_SPIN_CAP) { atomicAdd(&(bar)[XB_TMO], 1u); break; } } } } while (0)
__device__ __forceinline__ void xcd_barrier_complete(unsigned* bar, unsigned x, unsigned& nloc, unsigned& nx) {
    const unsigned G = gridDim.x * gridDim.y * gridDim.z;
    unsigned sum, cnt, mine, sp = 0u;
    for (;;) {
        sum = 0u; cnt = 0u; mine = 0u;
#pragma unroll
        for (unsigned j = 0; j < 16; ++j) { const unsigned c = xb_ld(&bar[XB_XCNT(j)]); sum += c; cnt += (c > 0u) ? 1u : 0u; mine = (j == x) ? c : mine; }
        if (sum == G) break;
        __builtin_amdgcn_s_sleep(1);
        if ((++sp & 255u) == 0u) { if (xb_ld(&bar[XB_TMO])) break; if (sp > XB_SPIN_CAP) { atomicAdd(&bar[XB_TMO], 1u); break; } }
    }
    nloc = mine > 0u ? mine : 1u; nx = cnt > 0u ? cnt : 1u;
}
__device__ __forceinline__ void xcd_barrier(unsigned* bar, unsigned x, volatile LAS unsigned* st) {
    asm volatile("s_waitcnt vmcnt(0)" ::: "memory");
    __syncthreads();
    if (threadIdx.x == 0) {
        __builtin_amdgcn_s_waitcnt(0);
        unsigned nloc = st[0], nx = st[1];
        if (nloc == 0u) { xcd_barrier_complete(bar, x, nloc, nx); st[0] = nloc; st[1] = nx; }
        const unsigned old = xb_add(&bar[XB_XSUB(x)], 1u);
        const unsigned gen = old / nloc;
        if (old + 1u == (gen + 1u) * nloc) {
            __builtin_amdgcn_fence(__ATOMIC_RELEASE, "agent");
            asm volatile("s_waitcnt vmcnt(0)" ::: "memory");
            const unsigned og = xb_add(&bar[XB_TOP], 1u);
            const unsigned tg = og / nx;
            if (og + 1u == (tg + 1u) * nx) xb_add(&bar[XB_TOPGEN], 1u);
            else XB_SPIN(xb_ld(&bar[XB_TOPGEN]) == tg, bar);
            __builtin_amdgcn_fence(__ATOMIC_ACQUIRE, "agent");
            xb_add(&bar[XB_XGEN(x)], 1u);
            asm volatile("s_waitcnt vmcnt(0)" ::: "memory");
        } else {
            XB_SPIN(xb_ld(&bar[XB_XGEN(x)]) == gen, bar);
            __builtin_amdgcn_fence(__ATOMIC_ACQUIRE, "agent");
            asm volatile("s_waitcnt vmcnt(0)" ::: "memory");
        }
    }
    __syncthreads();
}

constexpr int LDS_BYTES = 131072 + 1024;
constexpr size_t WS_BAR = WS_END;
#ifndef PHMASK
#define PHMASK 0xffff
#endif
#define PHM(b) ((PHMASK & (b)) != 0)
constexpr unsigned SS_OFF(int k) { return (unsigned)(WS_SS + (size_t)k * MTOK * 4); }

__global__ void __launch_bounds__(512) fwd_kernel(Args a) {
    extern __shared__ __attribute__((aligned(16))) unsigned char lds_raw[];
    LAS unsigned char* lds = (LAS unsigned char*)lds_raw;
    cg::grid_group grid = cg::this_grid();
    volatile LAS unsigned* bst = (volatile LAS unsigned*)(lds + 131072);
    if (threadIdx.x < 2) bst[threadIdx.x] = 0u;
    unsigned* barw = (unsigned*)(a.ws + WS_BAR);
    const unsigned myxcc = xb_xcc_id();
    if (threadIdx.x == 0) (void)xb_add(&barw[XB_XCNT(myxcc)], 1u);
    __syncthreads();

    for (int ph = a.ph_lo; ph < a.ph_hi; ++ph) {
        int tid = threadIdx.x, G = gridDim.x, bx = blockIdx.x; asm volatile("" : "+v"(tid), "+s"(G), "+s"(bx));
        gptr ws = (gptr)a.ws; gptr X = (gptr)a.out; asm volatile("" : "+s"(ws), "+s"(X));
        const int lane = tid & 63, wave = __builtin_amdgcn_readfirstlane(tid >> 6);
        const int gw = bx * 8 + wave, ngw = G * 8;
        if (PHM(128) && ph == 0) {
            const GAS float* xp = inptr(0); const GAS float* xs = inptr(1);
            for (int m = gw; m < MTOK; m += ngw) {
                const GAS float* src = (m < NPROMPT) ? xp + (size_t)m * DM : xs + (size_t)(m - NPROMPT) * DM;
                float s = 0.f;
#pragma unroll
                for (int jj = 0; jj < 4; ++jj) { const f32x4 v = *(const GAS f32x4*)(src + jj * 256 + lane * 4);
                    u32x2 w; w.x = cvt_pk_bf16(v[0], v[1]); w.y = cvt_pk_bf16(v[2], v[3]); *WSP(u32x2, WS_XB + (unsigned)m * (DM * 2) + (jj * 256 + lane * 4) * 2) = w;
                    s += (v[0] * v[0] + v[1] * v[1]) + (v[2] * v[2] + v[3] * v[3]); }
                s = wave_sum(s);
                if (lane < 16) *WSP(float, SSP_OFF + (unsigned)m * 64u + lane * 4u) = (lane == 0) ? s : 0.f;
            }
            for (int i = bx * 512 + tid; i < SEQS * 48; i += G * 512) {
                int pos, fi; unsigned dst;
                if (i < SEQS * 16) { pos = i >> 4; fi = i & 15; dst = (unsigned)WS_TAB32 + (unsigned)i * 8u; }
                else { const int k = i - SEQS * 16; pos = k >> 5; fi = 16 + (k & 31); dst = (unsigned)WS_TAB64 + (unsigned)k * 8u; }
                const float ang = (float)pos * ROPE_FREQ[fi];
                const double rev = (double)ang * 0.15915494309189535;
                const float fr_ = (float)(rev - __builtin_rint(rev));
                f32x2 cs; cs.x = __builtin_amdgcn_cosf(fr_); cs.y = __builtin_amdgcn_sinf(fr_); *WSP(f32x2, dst) = cs;
            }
            { int rot = 0; prep_layer(ws, 0, (LAS float*)(lds + wave * 16384), gw, ngw, lane, 1, rot); }
        } else if (ph >= 1000) {
            const int code = ph - 1000;
            unsigned offA, pitA, offB, pitB;
            if (code == 0) { offA = WS_MIX + MX_QN; pitA = 1024; offB = WS_MIX + MX_GQ; pitB = 1024; }
            else if (code == 1) { offA = WS_MIX + MX_KN; pitA = 1024; offB = WS_MIX + MX_QP; pitB = 512; }
            else if (code == 2) { offA = WS_MIX + MX_GA; pitA = 2048; offB = WS_MIX + MX_GB; pitB = 2048; }
            else if (code == 3) { offA = WS_MIX + MX_CQ; pitA = 512; offB = WS_MIX + MX_CKV; pitB = 512; }
            else { offA = WS_MIX + MX_VT; pitA = 1024; offB = WS_MIX + MX_GVT; pitB = 256; }
            for (int m = gw; m < MTOK; m += ngw) {
#pragma unroll
                for (int half = 0; half < 2; ++half) {
                    const unsigned so = (half ? offB + (unsigned)m * pitB : offA + (unsigned)m * pitA) + lane * 16;
                    const u32x4 w = *WSP(const u32x4, so); f32x4 a0, a1; unpack8(w, a0, a1);
                    GAS f32x4* dp = (GAS f32x4*)(X + (unsigned)(m * 4096 + half * 2048 + lane * 32)); dp[0] = a0; dp[1] = a1;
                }
            }
        } else if (ph == NPHASE - 1) {
            const GAS float* g = inptr(20);
            for (int m = gw; m < MTOK; m += ngw) {
                const float rs = rstd(sum16(ws, SSP_OFF, m), 1.0f / DM);
#pragma unroll
                for (int jj = 0; jj < 4; ++jj) { GAS f32x4* p = (GAS f32x4*)(X + (unsigned)(m * (DM * 4) + (jj * 256 + lane * 4) * 4)); const f32x4 gv = *(const GAS f32x4*)(g + jj * 256 + lane * 4);
                    const u32x2 w = *WSP(const u32x2, WS_XB + (unsigned)m * (DM * 2) + (jj * 256 + lane * 4) * 2);
                    f32x4 xv; xv[0] = __uint_as_float(w.x << 16); xv[1] = __uint_as_float(w.x & 0xffff0000u); xv[2] = __uint_as_float(w.y << 16); xv[3] = __uint_as_float(w.y & 0xffff0000u);
                    *p = xv * rs * gv; }
            }
        } else if (ph > 0) {
            const int l = (ph - 1) / 10, sraw = (ph - 1) % 10;
            const int sub = sraw < 4 ? sraw : (sraw == 4 ? 9 : sraw - 1);
            pg8::StaticOrder S;
            if (PHM(1) && (sub == 0 || sub == 7)) {
                pg8::Gemm g{WSP(const bf16_t, WS_XB), WSP(const bf16_t, WS_W + (sub == 0 ? W_13A : W_13B)), MTOK, 2 * FF, DM, DM, DM}; S.init(MTOK, 2 * FF, G, bx);
                EpiSwiglu E{ws};
                pg8::gemm_phase(lds, g, S, E);
            } else if (PHM(2) && (sub == 1 || sub == 8)) {
                pg8::Gemm g{WSP(const bf16_t, WS_MIX), WSP(const bf16_t, WS_W + (sub == 1 ? W_2A : W_2B)), MTOK, DM, FF, FF, FF}; S.init(MTOK, DM, G, bx, 1);
                EpiResid E{ws, 0.5f};
                pg8::gemm_phase(lds, g, S, E);
            } else if (PHM(4) && sub == 2) {
                { pg8::Gemm g{WSP(const bf16_t, WS_XB), WSP(const bf16_t, WS_W + W_IN), MTOK, 3328, DM, DM, DM}; S.init(MTOK, 3328, G, bx);
                  EpiWin E{ws};
                  pg8::gemm_phase(lds, g, S, E); }
                { pg8::Gemm g{WSP(const bf16_t, WS_W + W_GVA), WSP(const bf16_t, WS_XB), 256, MTOK, DM, DM, DM}; S.init(256, MTOK, G, (bx + (G >> 1)) % G);
                  EpiVt E{ws, 1, 1.0f / DM, (unsigned)(WS_MIX + MX_GVT), 1};
                  pg8::gemm_phase(lds, g, S, E); }
            } else if (PHM(8) && sub == 3) {
#ifndef S3
#define S3 7
#endif
                if (S3 & 1) { pg8::Gemm g{WSP(const bf16_t, WS_MIX + MX_CQ), WSP(const bf16_t, WS_W + W_UQ), MTOK, 768, 256, 256, 256}; S.init(MTOK, 768, G, bx);
                  EpiQ E{ws};
                  pg8::gemm_phase(lds, g, S, E); }
                if (S3 & 2) { pg8::Gemm g{WSP(const bf16_t, WS_MIX + MX_CKV), WSP(const bf16_t, WS_W + W_KN), MTOK, 512, 128, 256, 128}; S.init(MTOK, 512, G, bx);
                  EpiKn E{ws};
                  pg8::gemm_phase(lds, g, S, E); }
                if (S3 & 4) { pg8::Gemm g{WSP(const bf16_t, WS_W + W_VT), WSP(const bf16_t, WS_MIX + MX_CKV), 512, MTOK, 128, 128, 256}; S.init(512, MTOK, G, bx);
                  EpiVt E{ws, 0, 1.0f / 128.0f, (unsigned)(WS_MIX + MX_VT), 2};
                  pg8::gemm_phase(lds, g, S, E); }
            } else if (PHM(16) && sub == 4) {
#ifndef ATT_REPS
#define ATT_REPS 1
#endif
                for (int rep = 0; rep < ATT_REPS; ++rep) {
                const int xcd = bx & 7, idx = bx >> 3, per = G >> 3;
                const int h = xcd;
                for (int u = idx; u < 128; u += per) {
                    int row, lo, hi;
                    if (u < 64) { row = NPROMPT + u * 256 + wave * 32; lo = NPROMPT; hi = MTOK; }
                    else { const int v = u - 64, sq = v >> 3; row = sq * SEQP + (v & 7) * 256 + wave * 32; lo = sq * SEQP; hi = lo + SEQP; }
                    ATTN_FN<3, false>(lds, ws, (unsigned)(WS_MIX + MX_QN) + (unsigned)row * 1024 + h * 128, 1024, (unsigned)(WS_MIX + MX_QP) + (unsigned)row * 512 + h * 64, 512, row,
                        (unsigned)(WS_MIX + MX_KN) + h * 128, 1024, (unsigned)(WS_MIX + MX_CKV) + 256, 512, (unsigned)(WS_MIX + MX_VT) + (unsigned)(h * 64) * (MTOK * 2), lo, hi, 0.f, (rep == 0 && ATT_REPS > 1) ? (unsigned)WS_XB + (unsigned)row * 1024 + h * 128 : (unsigned)(WS_MIX + MX_QN) + (unsigned)row * 1024 + h * 128);
                }
                const GAS float* sink = inptr(13) + l * 8;
                for (int u = bx; u < 1024; u += G) {
                    const int blk = u >> 2, kh = (u >> 1) & 1, hp = u & 1, head = kh * 4 + hp * 2 + (wave >> 2);
                    const int q0 = blk * 128, row = q0 + (wave & 3) * 32;
                    const int s_lo = q0 < NPROMPT ? (q0 & ~(SEQP - 1)) : NPROMPT, s_hi = q0 < NPROMPT ? s_lo + SEQP : MTOK;
                    const int lo = (q0 - 128 > s_lo) ? q0 - 128 : s_lo, hi = (q0 + 256 < s_hi) ? q0 + 256 : s_hi;
                    ATTN_FN<2, true>(lds, ws, (unsigned)(WS_MIX + MX_GQ) + (unsigned)row * 1024 + head * 128, 1024, 0, 0, row,
                        (unsigned)(WS_MIX + MX_GK) + kh * 128, 256, 0, 0, (unsigned)(WS_MIX + MX_GVT) + (unsigned)(kh * 64) * (MTOK * 2), lo, hi, sink[head] * LOG2E, (rep == 0 && ATT_REPS > 1) ? (unsigned)(WS_XB + 32 * MiB) + (unsigned)row * 1024 + head * 128 : (unsigned)(WS_MIX + MX_GQ) + (unsigned)row * 1024 + head * 128);
                }
                }
            } else if (PHM(32) && sub == 5) {
                { pg8::Gemm g{WSP(const bf16_t, WS_MIX + MX_GQ), WSP(const bf16_t, WS_W + W_OB), MTOK, DM, 1024, 512, 512, WSP(const bf16_t, WS_MIX + MX_QN), WSP(const bf16_t, WS_W + W_OA), 8}; S.init(MTOK, DM, G, bx);
                  EpiGateDual E{ws};
                  pg8::gemm_phase(lds, g, S, E); }
            } else if (PHM(64) && sub == 6) {
                pg8::Gemm g{WSP(const bf16_t, WS_MIX + MX_GA), WSP(const bf16_t, WS_W + W_OUT), MTOK, DM, DM, DM, DM}; S.init(MTOK, DM, G, bx, 1);
                EpiResid E{ws, 1.0f};
                pg8::gemm_phase(lds, g, S, E);
            } else if (PHM(256) && sub == 9) {
                { int rot = 0; prep_layer(ws, l, (LAS float*)(lds + wave * 16384), gw, ngw, lane, 2, rot);
                  if (l + 1 < NL) prep_layer(ws, l + 1, (LAS float*)(lds + wave * 16384), gw, ngw, lane, 1, rot); }
            }
        }
        if (ph + 1 < a.ph_hi) { if (ph == a.ph_lo) grid.sync(); else xcd_barrier(barw, myxcc, bst); }
    }
}

extern "C" void kernel_launch(void* const* d_in, const int* in_sizes, int n_in, void* d_out, int out_size, void* d_ws, size_t ws_size, hipStream_t stream) {
    static int grid = 0;
    if (grid == 0) {
        if (n_in != 21 || out_size != MTOK * DM || ws_size < WS_END + 65536) { fprintf(stderr, "kernel_launch: unexpected shapes (n_in %d out %d ws %zu)\n", n_in, out_size, ws_size); grid = -1; return; }
        int dev = 0, cus = 0, per_cu = 0;
        (void)hipGetDevice(&dev); (void)hipDeviceGetAttribute(&cus, hipDeviceAttributeMultiprocessorCount, dev);
        (void)hipFuncSetAttribute((const void*)fwd_kernel, hipFuncAttributeMaxDynamicSharedMemorySize, LDS_BYTES);
        (void)hipOccupancyMaxActiveBlocksPerMultiprocessor(&per_cu, (const void*)fwd_kernel, 512, LDS_BYTES);
        (void)hipGetLastError();
        grid = cus;
        if (grid <= 0 || grid % 8 != 0 || grid > 512) grid = 256;
    }
    if (grid < 0) return;
    (void)hipMemsetAsync((char*)d_ws + WS_BAR, 0, 16384, stream);
    Args a{};
    for (int i = 0; i < 21; ++i) a.in[i] = (const float*)d_in[i];
    a.out = (float*)d_out; a.ws = (unsigned char*)d_ws;
#ifndef ONE_LAUNCH
#define ONE_LAUNCH 1
#endif
#if ONE_LAUNCH
    a.ph_lo = 0; a.ph_hi = NPHASE;
    void* args[] = {&a};
    hipError_t e = hipLaunchCooperativeKernel((const void*)fwd_kernel, dim3(grid), dim3(512), args, LDS_BYTES, stream);
    if (e != hipSuccess) fprintf(stderr, "cooperative launch failed: %s (grid %d)\n", hipGetErrorString(e), grid);
#else
#ifndef DBG_STOP
#define DBG_STOP -1
#endif
#ifndef DBG_DUMP
#define DBG_DUMP -1
#endif
    for (int ph = 0; ph < NPHASE; ++ph) {
        if (DBG_STOP >= 0 && ph > DBG_STOP) break;
        a.ph_lo = ph; a.ph_hi = ph + 1;
        hipLaunchKernelGGL(fwd_kernel, dim3(grid), dim3(512), LDS_BYTES, stream, a);
    }
    if (DBG_DUMP >= 0) { a.ph_lo = 1000 + DBG_DUMP; a.ph_hi = a.ph_lo + 1; hipLaunchKernelGGL(fwd_kernel, dim3(grid), dim3(512), LDS_BYTES, stream, a); }
#endif
}
```

```cpp
#include <hip/hip_runtime.h>
#include <hip/hip_cooperative_groups.h>
#include <cstdio>
#include <cstdint>
namespace cg = cooperative_groups;

#define LAS __attribute__((address_space(3)))
#ifndef ATT32
#define ATT32 0
#endif
typedef unsigned short bf16_t;
typedef short bf16x8 __attribute__((ext_vector_type(8)));
typedef float f32x4 __attribute__((ext_vector_type(4)));
typedef float f32x2 __attribute__((ext_vector_type(2)));
typedef unsigned u32x4 __attribute__((ext_vector_type(4)));
typedef unsigned u32x2 __attribute__((ext_vector_type(2)));
#define GAS __attribute__((address_space(1)))
typedef GAS unsigned char* gptr;

constexpr int MTOK = 32768, DM = 1024, FF = 2816, NL = 4;
constexpr int SEQP = 2048, NPROMPT = 16384, SEQS = 16384;
constexpr float EPS = 1e-6f;
constexpr float LOG2E = 1.4426950408889634f;
constexpr float QS_MLA = 0.10206207261596575f * LOG2E;
constexpr float QS_GQA = 0.125f * LOG2E;
constexpr int NPHASE = 1 + 10 * NL;

constexpr size_t MiB = (size_t)1 << 20;
constexpr size_t WS_TAB32 = 0, WS_TAB64 = 2 * MiB, WS_SS = 6 * MiB, WS_W = 9 * MiB, WS_XB = 54 * MiB, WS_MIX = 118 * MiB;
constexpr size_t MX_CQ = 0, MX_CKV = 16 * MiB, MX_GQ = 32 * MiB, MX_GK = 64 * MiB, MX_GVT = 72 * MiB, MX_GA = 80 * MiB, MX_GB = 144 * MiB,
                 MX_QN = 208 * MiB, MX_QP = 240 * MiB, MX_KN = 256 * MiB, MX_VT = 288 * MiB;
constexpr size_t WS_END = WS_MIX + 320 * MiB;
constexpr size_t W_13A = 0, W_2A = 11 * MiB, W_13B = 16 * MiB + 512 * 1024, W_2B = 27 * MiB + 512 * 1024, W_IN = 33 * MiB, W_GVA = 39 * MiB + 512 * 1024,
                 W_UQ = 40 * MiB, W_KN = 40 * MiB + 384 * 1024, W_VT = 40 * MiB + 512 * 1024, W_OA = 40 * MiB + 640 * 1024, W_OB = 41 * MiB + 640 * 1024, W_OUT = 42 * MiB + 640 * 1024;

typedef __bf16 bf16x2_t __attribute__((ext_vector_type(2)));
__device__ __forceinline__ unsigned cvt_pk_bf16(float lo, float hi) { f32x2 v = {lo, hi}; bf16x2_t b = __builtin_convertvector(v, bf16x2_t); return __builtin_bit_cast(unsigned, b); }
__device__ __forceinline__ u32x4 pack8(f32x4 a, f32x4 b) { u32x4 w; w.x = cvt_pk_bf16(a[0], a[1]); w.y = cvt_pk_bf16(a[2], a[3]); w.z = cvt_pk_bf16(b[0], b[1]); w.w = cvt_pk_bf16(b[2], b[3]); return w; }
__device__ __forceinline__ float bf2f(unsigned short h) { return __uint_as_float((unsigned)h << 16); }
__device__ __forceinline__ void unpack8(u32x4 w, f32x4& a, f32x4& b) {
    a[0] = __uint_as_float(w.x << 16); a[1] = __uint_as_float(w.x & 0xffff0000u); a[2] = __uint_as_float(w.y << 16); a[3] = __uint_as_float(w.y & 0xffff0000u);
    b[0] = __uint_as_float(w.z << 16); b[1] = __uint_as_float(w.z & 0xffff0000u); b[2] = __uint_as_float(w.w << 16); b[3] = __uint_as_float(w.w & 0xffff0000u); }
__device__ __forceinline__ float rstd(float ss, float invn) { float t = ss * invn; asm volatile("" : "+v"(t)); t += EPS; return rsqrtf(t); }
__device__ __forceinline__ int tok_pos(int row) { return row < NPROMPT ? (row & (SEQP - 1)) : row - NPROMPT; }

namespace pg8 {
constexpr int BM = 256, BK = 64, HALF = 128, HTB = HALF * BK * 2, STAGE_BYTES = 8 * HTB, NXCD = 8, WGM = 8;
__host__ __device__ __forceinline__ int lds_byte(int r, int c) { const int st = (r >> 4) * 2 + (c >> 5), rr = r & 15, cc = c & 31, ob = rr * 64 + cc * 2; return st * 1024 + (ob ^ (((ob >> 9) & 1) << 5)); }
__host__ __device__ __forceinline__ void stage_rc(int b, int& R, int& C) { const int st = b / 1024, sb = b % 1024, swz = sb ^ (((sb >> 9) & 1) << 5); R = (st >> 1) * 16 + swz / 64; C = (st & 1) * 32 + (swz % 64) / 2; }
__host__ __device__ __forceinline__ int perm32(int rho) { const int n = rho >> 4, i = rho & 15; return 8 * (i >> 2) + 4 * n + (i & 3); }

struct Unit { int pm, pn; };
struct Gemm { const GAS bf16_t* A; const GAS bf16_t* Bt; int M, N, K, lda, ldb; const GAS bf16_t* A2; const GAS bf16_t* B2t; int nt1; };

struct StaticOrder {
    int nM, nN, nwg, G, c, rev;
    __device__ __forceinline__ void init(int M, int N, int G_, int c_, int rev_ = 0) { nM = M / BM; nN = N / BM; nwg = nM * nN; G = G_; c = c_; rev = rev_; }
    __device__ __forceinline__ bool next(int i, Unit& u) const {
        const long L = (long)i * G + c; if (L >= nwg) return false;
        int wgid = (int)L; { const int q = nwg / NXCD, r = nwg % NXCD, xcd = wgid % NXCD, off = wgid / NXCD; wgid = (xcd < r ? xcd * (q + 1) : r * (q + 1) + (xcd - r) * q) + off; }
        const int nig = WGM * nN, gid = wgid / nig, fm = gid * WGM, gsz = (nM - fm) < WGM ? (nM - fm) : WGM;
        u.pm = fm + ((wgid % nig) % gsz); u.pn = (wgid % nig) / gsz; if (rev) u.pm = nM - 1 - u.pm; return true;
    }
};

template <class Epi>
__device__ __forceinline__ void gemm_phase(LAS unsigned char* lds, const Gemm g, const StaticOrder& S, const Epi& E) {
    int tid = threadIdx.x; asm volatile("" : "+v"(tid));
    const int wid = __builtin_amdgcn_readfirstlane(tid >> 6), lane = tid & 63, wr = wid >> 2, wc = wid & 3, fr = lane & 15, fq = lane >> 4;
    int K = g.K; asm volatile("" : "+s"(K));
    const int nt = K / BK;
    unsigned voffA[2], voffB[2];
#pragma unroll
    for (int i = 0; i < 2; ++i) { int R, C; stage_rc(tid * 16 + i * 8192, R, C); const int Rb = Epi::PERM ? ((R & ~31) + perm32(R & 31)) : R;
        voffA[i] = (unsigned)(R * g.lda + C) * 2u; voffB[i] = (unsigned)(Rb * g.ldb + C) * 2u; }
    const size_t kstep = (size_t)(BK * 2);
    const size_t hstepA = (size_t)HALF * g.lda * 2, hstepB = (size_t)HALF * g.ldb * 2;
    const size_t tstepA = 2 * hstepA, tstepB = 2 * hstepB;
    const unsigned ldsw = (unsigned)wid * 1024u;
    const int aoff = lds_byte(wr * 64 + fr, fq * 8), boff = lds_byte(wc * 32 + fr, fq * 8);
#define PG8_SA(b, h) (((b) * 2 + (h)) * HTB)
#define PG8_SB(b, h) ((4 + (b) * 2 + (h)) * HTB)
#define PG8_STAGE(bufoff, gbase, voff) do { _Pragma("unroll") for (int _i = 0; _i < 2; ++_i) \
        __builtin_amdgcn_global_load_lds((const GAS unsigned*)((const GAS char*)(gbase) + (voff)[_i]), (LAS unsigned*)(lds + (bufoff) + ldsw + _i * 8192), 16, 0, 0); } while (0)
#define PG8_LDA(dst, b, h) do { _Pragma("unroll") for (int m = 0; m < 4; ++m) _Pragma("unroll") for (int k = 0; k < 2; ++k) dst[m][k] = *(const LAS bf16x8*)(lds + PG8_SA(b, h) + aoff + m * 2048 + k * 1024); } while (0)
#define PG8_LDB(dst, b, h) do { _Pragma("unroll") for (int n = 0; n < 2; ++n) _Pragma("unroll") for (int k = 0; k < 2; ++k) dst[n][k] = *(const LAS bf16x8*)(lds + PG8_SB(b, h) + boff + n * 2048 + k * 1024); } while (0)
#define PG8_MMA(ai, bj, At, Bt) do { __builtin_amdgcn_s_setprio(1); _Pragma("unroll") for (int m = 0; m < 4; ++m) _Pragma("unroll") for (int n = 0; n < 2; ++n) _Pragma("unroll") for (int k = 0; k < 2; ++k) \
        acc[ai][bj][m][n] = __builtin_amdgcn_mfma_f32_16x16x32_bf16(Bt[n][k], At[m][k], acc[ai][bj][m][n], 0, 0, 0); __builtin_amdgcn_s_setprio(0); } while (0)
#define PG8_WAIT_V(n) asm volatile("s_waitcnt vmcnt(" #n ")" ::: "memory")
#define PG8_WAIT_L(n) asm volatile("s_waitcnt lgkmcnt(" #n ")" ::: "memory")
#define PG8_BAR __builtin_amdgcn_s_barrier()
#define PG8_SCHED __builtin_amdgcn_sched_barrier(0)
    Unit cur, nxt; int ui = 0;
    if (!S.next(0, cur)) return;
    f32x4 acc[2][2][4][2];
#pragma unroll
    for (int a = 0; a < 2; ++a)
#pragma unroll
        for (int b = 0; b < 2; ++b)
#pragma unroll
            for (int m = 0; m < 4; ++m)
#pragma unroll
                for (int n = 0; n < 2; ++n) acc[a][b][m][n] = (f32x4){0.f, 0.f, 0.f, 0.f};
    bf16x8 At[4][2], B0[2][2], B1[2][2];
    const GAS char* cA = (const GAS char*)g.A + (size_t)cur.pm * tstepA; const GAS char* cB = (const GAS char*)g.Bt + (size_t)cur.pn * tstepB;
    const GAS char* cA2 = cA; const GAS char* cB2 = cB; int nt1 = nt;
    if constexpr (Epi::DUAL) { cA2 = (const GAS char*)g.A2 + (size_t)cur.pm * tstepA; cB2 = (const GAS char*)g.B2t + (size_t)cur.pn * tstepB; nt1 = g.nt1; }
#define PG8_TA(k) ((Epi::DUAL && (k) >= nt1) ? cA2 + (size_t)((k) - nt1) * kstep : cA + (size_t)(k) * kstep)
#define PG8_TB(k) ((Epi::DUAL && (k) >= nt1) ? cB2 + (size_t)((k) - nt1) * kstep : cB + (size_t)(k) * kstep)
    PG8_STAGE(PG8_SB(0, 0), cB, voffB); PG8_STAGE(PG8_SB(0, 1), cB + hstepB, voffB); PG8_STAGE(PG8_SA(0, 0), cA, voffA); PG8_STAGE(PG8_SA(0, 1), cA + hstepA, voffA);
    if (wr == 1) PG8_BAR;
    PG8_WAIT_V(2); PG8_BAR;
    PG8_STAGE(PG8_SB(1, 0), cB + kstep, voffB); PG8_STAGE(PG8_SA(1, 0), cA + kstep, voffA); PG8_STAGE(PG8_SB(1, 1), cB + hstepB + kstep, voffB);
    PG8_WAIT_V(6); PG8_BAR;
    for (;;) {
        const bool has_next = S.next(ui + 1, nxt);
        const GAS char* nA = has_next ? (const GAS char*)g.A + (size_t)nxt.pm * tstepA : cA; const GAS char* nB = has_next ? (const GAS char*)g.Bt + (size_t)nxt.pn * tstepB : cB;
#pragma unroll 1
        for (int t = 0; t < nt; t += 2) {
            const bool last = (t == nt - 2);
            if constexpr (Epi::DUAL) { if (t == nt1) E.mid(acc, cur, wr, wc, fr, fq); }
            const GAS char* a1 = PG8_TA(t + 1);
            const GAS char* a2 = last ? nA : PG8_TA(t + 2); const GAS char* b2 = last ? nB : PG8_TB(t + 2);
            const GAS char* a3 = a2 + kstep; const GAS char* b3 = b2 + kstep;
            PG8_LDB(B0, 0, 0); PG8_LDB(B1, 0, 1); PG8_SCHED; PG8_LDA(At, 0, 0); PG8_STAGE(PG8_SA(1, 1), a1 + hstepA, voffA);
            PG8_WAIT_V(8); PG8_WAIT_L(0); PG8_BAR; PG8_MMA(0, 0, At, B0); PG8_MMA(0, 1, At, B1); PG8_BAR; PG8_SCHED;
            PG8_LDA(At, 0, 1); PG8_STAGE(PG8_SB(0, 0), b2, voffB); PG8_STAGE(PG8_SB(0, 1), b2 + hstepB, voffB); PG8_STAGE(PG8_SA(0, 0), a2, voffA);
            PG8_WAIT_V(8); PG8_WAIT_L(0); PG8_BAR; PG8_MMA(1, 0, At, B0); PG8_MMA(1, 1, At, B1); PG8_BAR; PG8_SCHED;
            PG8_LDB(B0, 1, 0); PG8_LDB(B1, 1, 1); PG8_SCHED; PG8_LDA(At, 1, 0); PG8_STAGE(PG8_SA(0, 1), a2 + hstepA, voffA);
            PG8_WAIT_V(8); PG8_WAIT_L(0); PG8_BAR; PG8_MMA(0, 0, At, B0); PG8_MMA(0, 1, At, B1); PG8_BAR; PG8_SCHED;
            PG8_LDA(At, 1, 1); PG8_STAGE(PG8_SB(1, 0), b3, voffB); PG8_STAGE(PG8_SB(1, 1), b3 + hstepB, voffB); PG8_STAGE(PG8_SA(1, 0), a3, voffA);
            PG8_WAIT_V(8); PG8_WAIT_L(0); PG8_BAR; PG8_MMA(1, 0, At, B0); PG8_MMA(1, 1, At, B1); PG8_BAR; PG8_SCHED;
        }
        if (wr == 0) PG8_BAR;
        E(acc, cur, wr, wc, fr, fq);
        if (!has_next) break;
#pragma unroll
        for (int a = 0; a < 2; ++a)
#pragma unroll
            for (int b = 0; b < 2; ++b)
#pragma unroll
                for (int m = 0; m < 4; ++m)
#pragma unroll
                    for (int n = 0; n < 2; ++n) acc[a][b][m][n] = (f32x4){0.f, 0.f, 0.f, 0.f};
        cur = nxt; cA = nA; cB = nB; ++ui;
        if constexpr (Epi::DUAL) { cA2 = (const GAS char*)g.A2 + (size_t)cur.pm * tstepA; cB2 = (const GAS char*)g.B2t + (size_t)cur.pn * tstepB; }
        if (wr == 1) PG8_BAR;
    }
    PG8_WAIT_V(0);
    PG8_BAR;
#undef PG8_TA
#undef PG8_TB
#undef PG8_SA
#undef PG8_SB
#undef PG8_STAGE
#undef PG8_LDA
#undef PG8_LDB
#undef PG8_MMA
#undef PG8_WAIT_V
#undef PG8_WAIT_L
#undef PG8_BAR
#undef PG8_SCHED
}
}
using pg8::Unit;
typedef const f32x4 (&AccRef)[2][2][4][2];

__device__ __forceinline__ float silu_mul(float a, float b) { return a * __builtin_amdgcn_rcpf(1.0f + __builtin_amdgcn_exp2f(-a * LOG2E)) * b; }
__device__ __forceinline__ float sigmoidf_(float a) { return __builtin_amdgcn_rcpf(1.0f + __builtin_amdgcn_exp2f(-a * LOG2E)); }
__device__ __forceinline__ void rope8(f32x4& v0, f32x4& v1, const GAS f32x2* t) {
    const f32x4 t01 = *(const GAS f32x4*)(t), t23 = *(const GAS f32x4*)(t + 2);
    float a, b;
    a = v0[0]; b = v0[1]; v0[0] = a * t01[0] - b * t01[1]; v0[1] = b * t01[0] + a * t01[1];
    a = v0[2]; b = v0[3]; v0[2] = a * t01[2] - b * t01[3]; v0[3] = b * t01[2] + a * t01[3];
    a = v1[0]; b = v1[1]; v1[0] = a * t23[0] - b * t23[1]; v1[1] = b * t23[0] + a * t23[1];
    a = v1[2]; b = v1[3]; v1[2] = a * t23[2] - b * t23[3]; v1[3] = b * t23[2] + a * t23[3];
}

__device__ __forceinline__ void rope8r(f32x4& v0, f32x4& v1, const f32x4 t01, const f32x4 t23) {
    float a, b;
    a = v0[0]; b = v0[1]; v0[0] = a * t01[0] - b * t01[1]; v0[1] = b * t01[0] + a * t01[1];
    a = v0[2]; b = v0[3]; v0[2] = a * t01[2] - b * t01[3]; v0[3] = b * t01[2] + a * t01[3];
    a = v1[0]; b = v1[1]; v1[0] = a * t23[0] - b * t23[1]; v1[1] = b * t23[0] + a * t23[1];
    a = v1[2]; b = v1[3]; v1[2] = a * t23[2] - b * t23[3]; v1[3] = b * t23[2] + a * t23[3];
}
#define WSP(T, off) ((GAS T*)(ws + (unsigned)(off)))
#define DEFBASE(name, cst) gptr name = ws + (size_t)(cst); asm volatile("" : "+s"(name))
#define AT(T, base, var) ((GAS T*)((base) + (unsigned)(var)))
constexpr unsigned SSP_OFF = (unsigned)WS_SS, SSQP_OFF = (unsigned)(WS_SS + 2 * MiB), SSKVP_OFF = (unsigned)(WS_SS + 2 * MiB + 512 * 1024);
__device__ __forceinline__ float sum16(gptr ws, unsigned off, int row) {
    const GAS f32x4* p = (const GAS f32x4*)((ws + off) + (unsigned)((unsigned)row * 64u));
    const f32x4 a = p[0], b = p[1], c = p[2], d = p[3];
    return (((a[0] + a[1]) + (a[2] + a[3])) + ((b[0] + b[1]) + (b[2] + b[3]))) + (((c[0] + c[1]) + (c[2] + c[3])) + ((d[0] + d[1]) + (d[2] + d[3])));
}
__device__ __forceinline__ float sum4(gptr ws, unsigned off, int row) {
    const f32x4 a = *(const GAS f32x4*)((ws + off) + (unsigned)((unsigned)row * 16u));
    return (a[0] + a[1]) + (a[2] + a[3]);
}
__device__ __forceinline__ void rs_rows16(gptr ws, int row0, int fq, float invn, float (&rs)[2][4]) {
    f32x4 p[2][4];
#pragma unroll
    for (int ai = 0; ai < 2; ++ai)
#pragma unroll
        for (int m = 0; m < 4; ++m) p[ai][m] = *(const GAS f32x4*)((ws + SSP_OFF) + (unsigned)((row0 + ai * 128 + m * 16) * 64 + fq * 16));
#pragma unroll
    for (int ai = 0; ai < 2; ++ai)
#pragma unroll
        for (int m = 0; m < 4; ++m) { float s = (p[ai][m][0] + p[ai][m][1]) + (p[ai][m][2] + p[ai][m][3]); s += __shfl_xor(s, 16); s += __shfl_xor(s, 32); rs[ai][m] = rstd(s, invn); }
}
__device__ __forceinline__ void rs_rows4(gptr ws, unsigned off, int row0, int fq, float invn, float (&rs)[2][4]) {
    float p[2][4];
#pragma unroll
    for (int ai = 0; ai < 2; ++ai)
#pragma unroll
        for (int m = 0; m < 4; ++m) p[ai][m] = *(const GAS float*)((ws + off) + (unsigned)((row0 + ai * 128 + m * 16) * 16 + fq * 4));
#pragma unroll
    for (int ai = 0; ai < 2; ++ai)
#pragma unroll
        for (int m = 0; m < 4; ++m) { float s = p[ai][m]; s += __shfl_xor(s, 16); s += __shfl_xor(s, 32); rs[ai][m] = rstd(s, invn); }
}
struct EpiSwiglu {
    static constexpr bool PERM = true, DUAL = false;
    gptr ws;
    __device__ __forceinline__ void operator()(AccRef acc, const Unit& u, int wr, int wc, int fr, int fq) const {
        const int row0 = u.pm * 256 + wr * 64 + fr, col0 = u.pn * 128 + wc * 32 + fq * 8;
        DEFBASE(pH, WS_MIX);
        float rs[2][4]; rs_rows16(ws, row0, fq, 1.0f / DM, rs);
#pragma unroll
        for (int ai = 0; ai < 2; ++ai)
#pragma unroll
            for (int m = 0; m < 4; ++m) {
                const int row = row0 + ai * 128 + m * 16; const float r = rs[ai][m];
                f32x4 o0, o1;
#pragma unroll
                for (int j = 0; j < 4; ++j) { o0[j] = silu_mul(acc[ai][0][m][0][j] * r, acc[ai][1][m][0][j] * r); o1[j] = silu_mul(acc[ai][0][m][1][j] * r, acc[ai][1][m][1][j] * r); }
                *AT(u32x4, pH, (unsigned)row * (FF * 2) + col0 * 2) = pack8(o0, o1);
            }
    }
};
struct EpiResid {
    static constexpr bool PERM = true, DUAL = false;
    gptr ws; float scale;
    __device__ __forceinline__ void operator()(AccRef acc, const Unit& u, int wr, int wc, int fr, int fq) const {
        const int row0 = u.pm * 256 + wr * 64 + fr, col0 = u.pn * 256 + wc * 32 + fq * 8;
        DEFBASE(pXB, WS_XB);
        u32x4 xv[2][4][2];
#pragma unroll
        for (int ai = 0; ai < 2; ++ai)
#pragma unroll
            for (int m = 0; m < 4; ++m)
#pragma unroll
                for (int bj = 0; bj < 2; ++bj) xv[ai][m][bj] = *AT(const u32x4, pXB, (unsigned)(row0 + ai * 128 + m * 16) * (DM * 2) + (col0 + bj * 128) * 2);
#pragma unroll
        for (int ai = 0; ai < 2; ++ai)
#pragma unroll
            for (int m = 0; m < 4; ++m) {
                const int row = row0 + ai * 128 + m * 16; float q = 0.f;
#pragma unroll
                for (int bj = 0; bj < 2; ++bj) {
                    f32x4 x0, x1; unpack8(xv[ai][m][bj], x0, x1);
                    x0 = x0 + acc[ai][bj][m][0] * scale; x1 = x1 + acc[ai][bj][m][1] * scale;
                    *AT(u32x4, pXB, (unsigned)row * (DM * 2) + (col0 + bj * 128) * 2) = pack8(x0, x1);
                    q += (x0[0] * x0[0] + x0[1] * x0[1]) + (x0[2] * x0[2] + x0[3] * x0[3]) + (x1[0] * x1[0] + x1[1] * x1[1]) + (x1[2] * x1[2] + x1[3] * x1[3]);
                }
                q += __shfl_xor(q, 16); q += __shfl_xor(q, 32);
                if (fq == 0) *WSP(float, SSP_OFF + (unsigned)row * 64u + (unsigned)(u.pn * 4 + wc) * 4u) = q;
            }
    }
};
struct EpiWin {
    static constexpr bool PERM = true, DUAL = false;
    gptr ws;
    __device__ __forceinline__ void operator()(AccRef acc, const Unit& u, int wr, int wc, int fr, int fq) const {
        const int row0 = u.pm * 256 + wr * 64 + fr; const int pn = u.pn;
        float rs[2][4]; rs_rows16(ws, row0, fq, 1.0f / DM, rs);
        if (pn >= 5) {
            DEFBASE(pb, WS_MIX + MX_GA);
            const unsigned gofs = pn <= 8 ? (unsigned)(pn - 5) * 512u : (unsigned)(MX_GB - MX_GA) + (unsigned)(pn - 9) * 512u;
#pragma unroll
            for (int ai = 0; ai < 2; ++ai)
#pragma unroll
                for (int m = 0; m < 4; ++m)
#pragma unroll
                    for (int bj = 0; bj < 2; ++bj) {
                        const int row = row0 + ai * 128 + m * 16; const f32x4 v0 = acc[ai][bj][m][0] * rs[ai][m], v1 = acc[ai][bj][m][1] * rs[ai][m];
                        f32x4 s0, s1;
#pragma unroll
                        for (int j = 0; j < 4; ++j) { s0[j] = sigmoidf_(v0[j]); s1[j] = sigmoidf_(v1[j]); }
                        *AT(u32x4, pb, gofs + (unsigned)row * 2048 + (bj * 128 + wc * 32 + fq * 8) * 2) = pack8(s0, s1);
                    }
        } else if (pn >= 2) {
            DEFBASE(pt, WS_TAB64);
            gptr pb = ws + (pn == 4 ? (size_t)(WS_MIX + MX_GK) : (size_t)(WS_MIX + MX_GQ) + (size_t)(pn - 2) * 512); asm volatile("" : "+s"(pb));
            const unsigned pitch = pn == 4 ? 256u : 1024u; const float qs = pn == 4 ? 1.0f : QS_GQA;
#pragma unroll
            for (int ai = 0; ai < 2; ++ai) {
                f32x4 tb[4][2];
#pragma unroll
                for (int m = 0; m < 4; ++m) { const GAS f32x4* tp = AT(const f32x4, pt, (unsigned)tok_pos(row0 + ai * 128 + m * 16) * 256 + (wc & 1) * 128 + fq * 32); tb[m][0] = tp[0]; tb[m][1] = tp[1]; }
#pragma unroll
                for (int m = 0; m < 4; ++m)
#pragma unroll
                    for (int bj = 0; bj < 2; ++bj) {
                        if (pn == 4 && bj == 1) continue;
                        const int row = row0 + ai * 128 + m * 16; f32x4 v0 = acc[ai][bj][m][0] * rs[ai][m], v1 = acc[ai][bj][m][1] * rs[ai][m];
                        rope8r(v0, v1, tb[m][0], tb[m][1]);
                        *AT(u32x4, pb, (unsigned)row * pitch + (bj * 128 + wc * 32 + fq * 8) * 2) = pack8(v0 * qs, v1 * qs);
                    }
            }
        } else {
            gptr pb = ws + (pn == 0 ? (size_t)(WS_MIX + MX_CQ) : (size_t)(WS_MIX + MX_CKV)); asm volatile("" : "+s"(pb));
            DEFBASE(pt, WS_TAB32);
#pragma unroll
            for (int ai = 0; ai < 2; ++ai)
#pragma unroll
                for (int m = 0; m < 4; ++m) {
                    const int row = row0 + ai * 128 + m * 16; float q0 = 0.f;
#pragma unroll
                    for (int bj = 0; bj < 2; ++bj) {
                        f32x4 v0 = acc[ai][bj][m][0] * rs[ai][m], v1 = acc[ai][bj][m][1] * rs[ai][m];
                        const int lc = bj * 128 + wc * 32 + fq * 8;
                        if (pn == 0 || bj == 0) {
                            q0 += (v0[0] * v0[0] + v0[1] * v0[1]) + (v0[2] * v0[2] + v0[3] * v0[3]) + (v1[0] * v1[0] + v1[1] * v1[1]) + (v1[2] * v1[2] + v1[3] * v1[3]);
                            *AT(u32x4, pb, (unsigned)row * 512 + lc * 2) = pack8(v0, v1);
                        } else if (wc == 0) {
                            const GAS f32x4* tp = AT(const f32x4, pt, (unsigned)tok_pos(row) * 128 + fq * 32);
                            rope8r(v0, v1, tp[0], tp[1]); *AT(u32x4, pb, (unsigned)row * 512 + lc * 2) = pack8(v0, v1);
                        }
                    }
                    q0 += __shfl_xor(q0, 16); q0 += __shfl_xor(q0, 32);
                    if (fq == 0) *WSP(float, (pn == 0 ? SSQP_OFF : SSKVP_OFF) + (unsigned)row * 16u + (unsigned)wc * 4u) = q0;
                }
        }
    }
};
struct EpiQ {
    static constexpr bool PERM = true, DUAL = false;
    gptr ws;
    __device__ __forceinline__ void operator()(AccRef acc, const Unit& u, int wr, int wc, int fr, int fq) const {
        const int row0 = u.pm * 256 + wr * 64 + fr;
        float rs[2][4]; rs_rows4(ws, SSQP_OFF, row0, fq, 1.0f / 256.0f, rs);
#pragma unroll
        for (int bj = 0; bj < 2; ++bj) {
            const int g = u.pn * 8 + bj * 4 + wc, head = g / 3, part = g - head * 3;
            if (part < 2) {
                DEFBASE(pb, WS_MIX + MX_QN);
                const unsigned co = (unsigned)(head * 64 + part * 32 + fq * 8) * 2;
#pragma unroll
                for (int ai = 0; ai < 2; ++ai)
#pragma unroll
                    for (int m = 0; m < 4; ++m) { const int row = row0 + ai * 128 + m * 16; const float r = rs[ai][m] * QS_MLA;
                        *AT(u32x4, pb, (unsigned)row * 1024 + co) = pack8(acc[ai][bj][m][0] * r, acc[ai][bj][m][1] * r); }
            } else {
                DEFBASE(pt, WS_TAB32); DEFBASE(pb, WS_MIX + MX_QP);
                const unsigned co = (unsigned)(head * 32 + fq * 8) * 2;
#pragma unroll
                for (int ai = 0; ai < 2; ++ai) {
                    f32x4 tb[4][2];
#pragma unroll
                    for (int m = 0; m < 4; ++m) { const GAS f32x4* tp = AT(const f32x4, pt, (unsigned)tok_pos(row0 + ai * 128 + m * 16) * 128 + fq * 32); tb[m][0] = tp[0]; tb[m][1] = tp[1]; }
#pragma unroll
                    for (int m = 0; m < 4; ++m) { const int row = row0 + ai * 128 + m * 16; const float r = rs[ai][m] * QS_MLA;
                        f32x4 v0 = acc[ai][bj][m][0] * r, v1 = acc[ai][bj][m][1] * r;
                        rope8r(v0, v1, tb[m][0], tb[m][1]); *AT(u32x4, pb, (unsigned)row * 512 + co) = pack8(v0, v1); }
                }
            }
        }
    }
};
struct EpiKn {
    static constexpr bool PERM = true, DUAL = false;
    gptr ws;
    __device__ __forceinline__ void operator()(AccRef acc, const Unit& u, int wr, int wc, int fr, int fq) const {
        const int row0 = u.pm * 256 + wr * 64 + fr, col0 = u.pn * 256 + wc * 32 + fq * 8;
        float rs[2][4]; rs_rows4(ws, SSKVP_OFF, row0, fq, 1.0f / 128.0f, rs);
        DEFBASE(pb, WS_MIX + MX_KN);
#pragma unroll
        for (int ai = 0; ai < 2; ++ai)
#pragma unroll
            for (int m = 0; m < 4; ++m) {
                const int row = row0 + ai * 128 + m * 16;
#pragma unroll
                for (int bj = 0; bj < 2; ++bj) *AT(u32x4, pb, (unsigned)row * 1024 + (col0 + bj * 128) * 2) = pack8(acc[ai][bj][m][0] * rs[ai][m], acc[ai][bj][m][1] * rs[ai][m]);
            }
    }
};
struct EpiVt {
    static constexpr bool PERM = false, DUAL = false;
    gptr ws; int wide; float invn; unsigned out_off; int nai;
    __device__ __forceinline__ void operator()(AccRef acc, const Unit& u, int wr, int wc, int fr, int fq) const {
        const int vrow0 = u.pm * 256 + wr * 64 + fr, tok0 = u.pn * 256 + wc * 32;
        gptr pb = ws + out_off; asm volatile("" : "+s"(pb));
        float myrs;
        { const int tok = tok0 + (fr >> 3) * 128 + ((fr >> 2) & 1) * 16 + fq * 4 + (fr & 3);
          float s;
          if (wide) { const GAS f32x4* p = (const GAS f32x4*)((ws + SSP_OFF) + (unsigned)(tok * 64)); const f32x4 a = p[0], b = p[1], c = p[2], d = p[3];
                      s = (((a[0] + a[1]) + (a[2] + a[3])) + ((b[0] + b[1]) + (b[2] + b[3]))) + (((c[0] + c[1]) + (c[2] + c[3])) + ((d[0] + d[1]) + (d[2] + d[3]))); }
          else { const f32x4 a = *(const GAS f32x4*)((ws + SSKVP_OFF) + (unsigned)(tok * 16)); s = (a[0] + a[1]) + (a[2] + a[3]); }
          myrs = rstd(s, invn); }
#pragma unroll
        for (int bj = 0; bj < 2; ++bj) {
            f32x4 sc[2];
#pragma unroll
            for (int n = 0; n < 2; ++n)
#pragma unroll
                for (int j = 0; j < 4; ++j) sc[n][j] = __shfl(myrs, fq * 16 + bj * 8 + n * 4 + j);
#pragma unroll
            for (int ai = 0; ai < 2; ++ai) {
                if (ai < nai) {
#pragma unroll
                    for (int m = 0; m < 4; ++m) {
                        const int vrow = vrow0 + ai * 128 + m * 16;
#if ATT32
#pragma unroll
                        for (int n = 0; n < 2; ++n) { const f32x4 v = acc[ai][bj][m][n] * sc[n]; u32x2 w; w.x = cvt_pk_bf16(v[0], v[1]); w.y = cvt_pk_bf16(v[2], v[3]);
                            *AT(u32x2, pb, (unsigned)vrow * (MTOK * 2) + (tok0 + bj * 128 + n * 16 + 8 * (fq & 1) + 4 * (fq >> 1)) * 2) = w; }
#else
                        *AT(u32x4, pb, (unsigned)vrow * (MTOK * 2) + (tok0 + bj * 128 + fq * 8) * 2) = pack8(acc[ai][bj][m][0] * sc[0], acc[ai][bj][m][1] * sc[1]);
#endif
                    }
                }
            }
        }
    }
};
struct EpiGateDual {
    static constexpr bool PERM = true, DUAL = true;
    gptr ws;
    __device__ __forceinline__ void mid(f32x4 (&acc)[2][2][4][2], const Unit& u, int wr, int wc, int fr, int fq) const {
        const int row0 = u.pm * 256 + wr * 64 + fr, col0 = u.pn * 256 + wc * 32 + fq * 8;
        DEFBASE(pa, WS_MIX + MX_GA); DEFBASE(pg, WS_MIX + MX_GB);
#pragma unroll
        for (int ai = 0; ai < 2; ++ai) {
            u32x4 ga[4][2], gb[4][2];
#pragma unroll
            for (int m = 0; m < 4; ++m)
#pragma unroll
                for (int bj = 0; bj < 2; ++bj) { const unsigned eo = (unsigned)(row0 + ai * 128 + m * 16) * 2048 + (col0 + bj * 128) * 2; ga[m][bj] = *AT(const u32x4, pa, eo); gb[m][bj] = *AT(const u32x4, pg, eo); }
#pragma unroll
            for (int m = 0; m < 4; ++m)
#pragma unroll
                for (int bj = 0; bj < 2; ++bj) { f32x4 g0, g1, h0, h1; unpack8(ga[m][bj], g0, g1); unpack8(gb[m][bj], h0, h1);
#pragma unroll
                    for (int j = 0; j < 4; ++j) { acc[ai][bj][m][0][j] *= h0[j] * __builtin_amdgcn_rcpf(fmaxf(g0[j], 1e-30f)); acc[ai][bj][m][1][j] *= h1[j] * __builtin_amdgcn_rcpf(fmaxf(g1[j], 1e-30f)); } }
        }
    }
    __device__ __forceinline__ void operator()(AccRef acc, const Unit& u, int wr, int wc, int fr, int fq) const {
        const int row0 = u.pm * 256 + wr * 64 + fr, col0 = u.pn * 256 + wc * 32 + fq * 8;
        DEFBASE(pa, WS_MIX + MX_GA);
#pragma unroll
        for (int ai = 0; ai < 2; ++ai) {
            u32x4 ga[4][2];
#pragma unroll
            for (int m = 0; m < 4; ++m)
#pragma unroll
                for (int bj = 0; bj < 2; ++bj) ga[m][bj] = *AT(const u32x4, pa, (unsigned)(row0 + ai * 128 + m * 16) * 2048 + (col0 + bj * 128) * 2);
#pragma unroll
            for (int m = 0; m < 4; ++m)
#pragma unroll
                for (int bj = 0; bj < 2; ++bj) { f32x4 g0, g1; unpack8(ga[m][bj], g0, g1);
#pragma unroll
                    for (int j = 0; j < 4; ++j) { g0[j] = fmaxf(g0[j], 1e-30f) * acc[ai][bj][m][0][j]; g1[j] = fmaxf(g1[j], 1e-30f) * acc[ai][bj][m][1][j]; }
                    *AT(u32x4, pa, (unsigned)(row0 + ai * 128 + m * 16) * 2048 + (col0 + bj * 128) * 2) = pack8(g0, g1); }
        }
    }
};
template <int MODE> struct EpiGate {
    static constexpr bool PERM = true, DUAL = false;
    gptr ws;
    __device__ __forceinline__ void operator()(AccRef acc, const Unit& u, int wr, int wc, int fr, int fq) const {
        const int row0 = u.pm * 256 + wr * 64 + fr, col0 = u.pn * 256 + wc * 32 + fq * 8;
        DEFBASE(pa, WS_MIX + MX_GA); DEFBASE(pt, WS_MIX + MX_KN); DEFBASE(pg, WS_MIX + MX_GB);
#pragma unroll
        for (int ai = 0; ai < 2; ++ai) {
            u32x4 ga[4][2], gb[4][2];
#pragma unroll
            for (int m = 0; m < 4; ++m)
#pragma unroll
                for (int bj = 0; bj < 2; ++bj) { const unsigned eo = (unsigned)(row0 + ai * 128 + m * 16) * 2048 + (col0 + bj * 128) * 2;
                    ga[m][bj] = *AT(const u32x4, MODE == 0 ? pa : pt, eo); if (MODE == 1) gb[m][bj] = *AT(const u32x4, pg, eo); }
#pragma unroll
            for (int m = 0; m < 4; ++m)
#pragma unroll
                for (int bj = 0; bj < 2; ++bj) { const unsigned eo = (unsigned)(row0 + ai * 128 + m * 16) * 2048 + (col0 + bj * 128) * 2;
                    f32x4 g0, g1; unpack8(ga[m][bj], g0, g1);
                    if (MODE == 0) { g0 = g0 * acc[ai][bj][m][0]; g1 = g1 * acc[ai][bj][m][1]; *AT(u32x4, pt, eo) = pack8(g0, g1); }
                    else { f32x4 h0, h1; unpack8(gb[m][bj], h0, h1); g0 = g0 + h0 * acc[ai][bj][m][0]; g1 = g1 + h1 * acc[ai][bj][m][1]; *AT(u32x4, pa, eo) = pack8(g0, g1); } }
        }
    }
};

#if ATT32
#define ATTN_FN attn_unit32
#else
#define ATTN_FN attn_unit
#endif
__device__ __forceinline__ float max3_asm(float a, float b, float c) { float r; asm("v_max3_f32 %0, %1, %2, %3" : "=v"(r) : "v"(a), "v"(b), "v"(c)); return r; }
constexpr int ATT_BUF = 20480;
template <int NDS, bool GQA>
__device__ __forceinline__ void attn_unit(LAS unsigned char* lds, gptr ws,
        unsigned qa_off, unsigned ldqa, unsigned qb_off, unsigned ldqb,
        int qrow,
        unsigned k0_off, unsigned ldk0, unsigned k1_off, unsigned ldk1,
        unsigned vt_off,
        int kv_lo, int kv_hi,
        float sinkl, unsigned o_off) {
    constexpr float THR = 8.0f;
    int tid = threadIdx.x; asm volatile("" : "+v"(tid));
    const int lane = tid & 63, fr = lane & 15, fq = lane >> 4;
    const int foff = (fr * 64 + fq * 16) ^ ((fr >> 3) << 5);
    constexpr int NPC = 4 * NDS + 8, PPW = (2 * NPC) / 8;
    constexpr int ATT_CH = 2 * ATT_BUF;
    const int wv = __builtin_amdgcn_readfirstlane(tid >> 6);
    unsigned gsrc[PPW]; int pdst[PPW]; unsigned pstr[PPW];
    {
        const int obp = lane * 16, ob = obp ^ (((obp >> 9) & 1) << 5), rr = ob >> 6, cc = (ob & 63) >> 4;
#pragma unroll
        for (int j = 0; j < PPW; ++j) {
            const int pc = wv + 8 * j, tt = pc / NPC, p = pc - tt * NPC;
            if (p < 4 * NDS) { const int kb = p / NDS, ds = p - kb * NDS, row = 64 * tt + 16 * kb + rr;
                if (NDS == 3 && ds == 2) { gsrc[j] = k1_off + (unsigned)(kv_lo + row) * ldk1 + cc * 16; pstr[j] = 128 * ldk1; }
                else { gsrc[j] = k0_off + (unsigned)(kv_lo + row) * ldk0 + ds * 64 + cc * 16; pstr[j] = 128 * ldk0; }
                pdst[j] = tt * ATT_BUF + p * 1024;
            } else { const int v = p - 4 * NDS, db = v >> 1, sl = v & 1;
                gsrc[j] = vt_off + (unsigned)(16 * db + rr) * (MTOK * 2) + (unsigned)(kv_lo + 64 * tt) * 2 + (sl * 4 + cc) * 16; pstr[j] = 256;
                pdst[j] = tt * ATT_BUF + 12288 + v * 1024; }
        }
    }
    bf16x8 qf[2][NDS];
#pragma unroll
    for (int qb = 0; qb < 2; ++qb) {
#pragma unroll
        for (int ds = 0; ds < 2; ++ds) qf[qb][ds] = *WSP(const bf16x8, qa_off + (unsigned)(qb * 16 + fr) * ldqa + ds * 64 + fq * 16);
        if (NDS == 3) qf[qb][NDS - 1] = *WSP(const bf16x8, qb_off + (unsigned)(qb * 16 + fr) * ldqb + fq * 16);
    }
    f32x4 o[4][2];
#pragma unroll
    for (int db = 0; db < 4; ++db) { o[db][0] = (f32x4){0.f, 0.f, 0.f, 0.f}; o[db][1] = (f32x4){0.f, 0.f, 0.f, 0.f}; }
    float NEG = -1e30f; asm volatile("" : "+s"(NEG));
    float mref[2];
    const int nt = (kv_hi - kv_lo) >> 6;
#define ATT_DMA(b) do { _Pragma("unroll") for (int j_ = 0; j_ < PPW; ++j_) { \
        __builtin_amdgcn_global_load_lds((const GAS unsigned*)(ws + gsrc[j_]), (LAS unsigned*)(lds + (b) * ATT_CH + pdst[j_]), 16, 0, 0); gsrc[j_] += pstr[j_]; } } while (0)
#define ATT_WAITBAR(N) asm volatile("s_waitcnt vmcnt(" #N ") lgkmcnt(0)\n\ts_barrier" ::: "memory")
#define ATT_QK(S, bufp, c0, c1) do { \
        _Pragma("unroll") for (int kb = 0; kb < 4; ++kb) { S[kb][0] = (f32x4){c0, c0, c0, c0}; S[kb][1] = (f32x4){c1, c1, c1, c1}; } \
        bf16x8 kf_[NDS][4]; \
        _Pragma("unroll") for (int ds = 0; ds < NDS; ++ds) _Pragma("unroll") for (int kb = 0; kb < 4; ++kb) kf_[ds][kb] = *(const LAS bf16x8*)((bufp) + (kb * NDS + ds) * 1024 + foff); \
        __builtin_amdgcn_sched_barrier(0); \
        _Pragma("unroll") for (int ds = 0; ds < NDS; ++ds) _Pragma("unroll") for (int kb = 0; kb < 4; ++kb) { \
            S[kb][0] = __builtin_amdgcn_mfma_f32_16x16x32_bf16(kf_[ds][kb], qf[0][ds], S[kb][0], 0, 0, 0); \
            S[kb][1] = __builtin_amdgcn_mfma_f32_16x16x32_bf16(kf_[ds][kb], qf[1][ds], S[kb][1], 0, 0, 0); } } while (0)
#define ATT_QKN(S, bufp) do { \
        bf16x8 kf_[NDS][4]; \
        _Pragma("unroll") for (int ds = 0; ds < NDS; ++ds) _Pragma("unroll") for (int kb = 0; kb < 4; ++kb) kf_[ds][kb] = *(const LAS bf16x8*)((bufp) + (kb * NDS + ds) * 1024 + foff); \
        __builtin_amdgcn_sched_barrier(0); \
        _Pragma("unroll") for (int ds = 0; ds < NDS; ++ds) _Pragma("unroll") for (int kb = 0; kb < 4; ++kb) { \
            S[kb][0] = __builtin_amdgcn_mfma_f32_16x16x32_bf16(kf_[ds][kb], qf[0][ds], ds == 0 ? negm0 : S[kb][0], 0, 0, 0); \
            S[kb][1] = __builtin_amdgcn_mfma_f32_16x16x32_bf16(kf_[ds][kb], qf[1][ds], ds == 0 ? negm1 : S[kb][1], 0, 0, 0); } } while (0)
#define ATT_MASK(S, kv0) do { if (GQA) { _Pragma("unroll") for (int qb = 0; qb < 2; ++qb) { const int qp = qrow + qb * 16 + fr; \
        _Pragma("unroll") for (int kb = 0; kb < 4; ++kb) _Pragma("unroll") for (int j = 0; j < 4; ++j) { const int d = qp - ((kv0) + kb * 16 + fq * 4 + j); if (d > 128 || d < -128) S[kb][qb][j] = NEG; } } } } while (0)
#define MX3(a, b, c) __builtin_fmaxf(__builtin_fmaxf((a), (b)), (c))
#define ATT_LMAX(S, qb) __builtin_fmaxf(MX3(MX3(MX3(S[0][qb][0], S[0][qb][1], S[0][qb][2]), S[0][qb][3], S[1][qb][0]), S[1][qb][1], S[1][qb][2]), \
                                        MX3(MX3(MX3(MX3(S[1][qb][3], S[2][qb][0], S[2][qb][1]), S[2][qb][2], S[2][qb][3]), S[3][qb][0], S[3][qb][1]), S[3][qb][2], S[3][qb][3]))
#define MX3A(a, b, c) max3_asm((a), (b), (c))
#define ATT_LMAXA(S, qb) MX3A(MX3A(MX3A(MX3A(S[0][qb][0], S[0][qb][1], S[0][qb][2]), S[0][qb][3], S[1][qb][0]), S[1][qb][1], S[1][qb][2]), S[1][qb][3], \
                              MX3A(MX3A(MX3A(MX3A(S[2][qb][0], S[2][qb][1], S[2][qb][2]), S[2][qb][3], S[3][qb][0]), S[3][qb][1], S[3][qb][2]), S[3][qb][3], S[3][qb][3]))
    ATT_DMA(0); ATT_DMA(1);
    ATT_WAITBAR(0);
    f32x4 sA[4][2], sB[4][2];
    ATT_QK(sA, lds, 0.f, 0.f);
    ATT_MASK(sA, kv_lo);
#pragma unroll
    for (int qb = 0; qb < 2; ++qb) {
        float mx = ATT_LMAX(sA, qb);
        mx = fmaxf(mx, __shfl_xor(mx, 16)); mx = fmaxf(mx, __shfl_xor(mx, 32));
        mref[qb] = (mx < -1e29f) ? 0.f : mx;
#pragma unroll
        for (int kb = 0; kb < 4; ++kb) sA[kb][qb] = sA[kb][qb] - mref[qb];
    }
    f32x4 negm0 = {-mref[0], -mref[0], -mref[0], -mref[0]}, negm1 = {-mref[1], -mref[1], -mref[1], -mref[1]};
    const short one_bf = (fr == 0) ? (short)0x3F80 : (short)0;
    const bf16x8 onesf = {one_bf, one_bf, one_bf, one_bf, one_bf, one_bf, one_bf, one_bf};
    f32x4 lacc[2] = {(f32x4){0.f, 0.f, 0.f, 0.f}, (f32x4){0.f, 0.f, 0.f, 0.f}};
    int cb = 0;
#define ATT_STEP(SC, SN, t, has1, ODD, BAR, ISSUE) do { \
        if (BAR) ATT_WAITBAR(0); \
        LAS unsigned char* bufc = lds + cb * ATT_CH + (ODD ? ATT_BUF : 0); \
        const int cbn = (cb == 2) ? 0 : cb + 1; \
        if (ISSUE) ATT_DMA((cb == 0) ? 2 : cb - 1); \
        if (has1) ATT_QKN(SN, (ODD ? lds + cbn * ATT_CH : lds + cb * ATT_CH + ATT_BUF)); \
        bf16x8 pf[2][2]; \
        _Pragma("unroll") for (int qb = 0; qb < 2; ++qb) { \
            _Pragma("unroll") for (int kb = 0; kb < 4; ++kb) _Pragma("unroll") for (int j = 0; j < 4; ++j) SC[kb][qb][j] = __builtin_amdgcn_exp2f(SC[kb][qb][j]); \
            _Pragma("unroll") for (int sl = 0; sl < 2; ++sl) pf[qb][sl] = __builtin_bit_cast(bf16x8, pack8(SC[2 * sl][qb], SC[2 * sl + 1][qb])); } \
        if (has1) ATT_MASK(SN, kv_lo + ((t) + 1) * 64); \
        bf16x8 vf_[2][4]; \
        _Pragma("unroll") for (int sl = 0; sl < 2; ++sl) _Pragma("unroll") for (int db = 0; db < 4; ++db) vf_[sl][db] = *(const LAS bf16x8*)(bufc + 12288 + (db * 2 + sl) * 1024 + foff); \
        _Pragma("unroll") for (int sl = 0; sl < 2; ++sl) { \
            _Pragma("unroll") for (int db = 0; db < 4; ++db) { \
                o[db][0] = __builtin_amdgcn_mfma_f32_16x16x32_bf16(vf_[sl][db], pf[0][sl], o[db][0], 0, 0, 0); \
                o[db][1] = __builtin_amdgcn_mfma_f32_16x16x32_bf16(vf_[sl][db], pf[1][sl], o[db][1], 0, 0, 0); } \
            lacc[0] = __builtin_amdgcn_mfma_f32_16x16x32_bf16(onesf, pf[0][sl], lacc[0], 0, 0, 0); \
            lacc[1] = __builtin_amdgcn_mfma_f32_16x16x32_bf16(onesf, pf[1][sl], lacc[1], 0, 0, 0); } \
        if (has1) { \
            const float l0 = ATT_LMAXA(SN, 0), l1 = ATT_LMAXA(SN, 1);     \
            if (__builtin_expect(__any((l0 > THR) || (l1 > THR)), 0)) { \
                _Pragma("unroll") for (int qb = 0; qb < 2; ++qb) { \
                    float mx = qb == 0 ? l0 : l1; \
                    mx = fmaxf(mx, __shfl_xor(mx, 16)); mx = fmaxf(mx, __shfl_xor(mx, 32)); \
                    const float dl = fmaxf(mx, 0.f), f = __builtin_amdgcn_exp2f(-dl); \
                    mref[qb] += dl; lacc[qb] = lacc[qb] * f; if (qb == 0) negm0 = negm0 - dl; else negm1 = negm1 - dl; \
                    _Pragma("unroll") for (int kb = 0; kb < 4; ++kb) SN[kb][qb] = SN[kb][qb] - dl; \
                    _Pragma("unroll") for (int db = 0; db < 4; ++db) o[db][qb] = o[db][qb] * f; } } } \
        if (ODD) cb = cbn; } while (0)
    int t = 0;
    for (; t + 4 < nt; t += 2) {
        ATT_STEP(sA, sB, t, true, false, false, false);
        ATT_STEP(sB, sA, t + 1, true, true, true, true);
    }
    ATT_STEP(sA, sB, t, true, false, false, false);
    ATT_STEP(sB, sA, t + 1, true, true, true, false);
    ATT_STEP(sA, sB, t + 2, true, false, false, false);
    ATT_STEP(sB, sA, t + 3, false, true, false, false);
    ATT_WAITBAR(0);
#undef ATT_STEP
#undef ATT_DMA
#undef ATT_WAITBAR
#undef ATT_QK
#undef ATT_QKN
#undef ATT_MASK
#undef ATT_LMAX
#undef ATT_LMAXA
#undef MX3A
#undef MX3
#pragma unroll
    for (int qb = 0; qb < 2; ++qb) {
        float l = __shfl(lacc[qb][0], fr);
        if (GQA) l += __builtin_amdgcn_exp2f(sinkl - mref[qb]);
        const float rl = 1.0f / l;
#pragma unroll
        for (int db = 0; db < 4; ++db) { const f32x4 v = o[db][qb] * rl; u32x2 w; w.x = cvt_pk_bf16(v[0], v[1]); w.y = cvt_pk_bf16(v[2], v[3]);
            *WSP(u32x2, o_off + (unsigned)(qb * 16 + fr) * ldqa + db * 32 + fq * 8) = w; }
    }
}


typedef float f32x16 __attribute__((ext_vector_type(16)));
template <int NDS, bool GQA>
__device__ __forceinline__ void attn_unit32(LAS unsigned char* lds, gptr ws,
        unsigned qa_off, unsigned ldqa, unsigned qb_off, unsigned ldqb, int qrow,
        unsigned k0_off, unsigned ldk0, unsigned k1_off, unsigned ldk1, unsigned vt_off,
        int kv_lo, int kv_hi, float sinkl, unsigned o_off) {
    constexpr float THR = 8.0f;
    constexpr int NSL = 2 * NDS;
    int tid = threadIdx.x; asm volatile("" : "+v"(tid));
    const int lane = tid & 63, r32 = lane & 31, hi = lane >> 5;
    const int sw = (r32 >> 2) & 3;
    const int foffE = r32 * 64 + ((hi ^ sw) << 4), foffO = r32 * 64 + (((2 + hi) ^ sw) << 4);
    constexpr int NPC = 4 * NDS + 8, PPW = (NPC + 7) / 8;
    const int wv = __builtin_amdgcn_readfirstlane(tid >> 6);
    unsigned gsrc[PPW]; int pdst[PPW]; unsigned pstr[PPW];
#pragma unroll
    for (int j = 0; j < PPW; ++j) {
        int p = wv + 8 * j; if (p >= NPC) p -= 8;
        if (p < 4 * NDS) { const int s = p >> 1, h = p & 1, kb = s / NDS, dp = s - kb * NDS, r = 16 * h + (lane >> 2), c = (lane & 3) ^ ((r >> 2) & 3), row = 32 * kb + r;
            if (NDS == 3 && dp == 2) { gsrc[j] = k1_off + (unsigned)(kv_lo + row) * ldk1 + c * 16; pstr[j] = 64 * ldk1; }
            else { gsrc[j] = k0_off + (unsigned)(kv_lo + row) * ldk0 + dp * 64 + c * 16; pstr[j] = 64 * ldk0; }
            pdst[j] = p * 1024;
        } else { const int v = p - 4 * NDS, s = v >> 1, h = v & 1, db = s >> 1, sp = s & 1, r = 16 * h + (lane >> 2), c = (lane & 3) ^ ((r >> 2) & 3);
            gsrc[j] = vt_off + (unsigned)(32 * db + r) * (MTOK * 2) + (unsigned)kv_lo * 2 + (sp * 4 + c) * 16; pstr[j] = 128;
            pdst[j] = 12288 + v * 1024; }
    }
    bf16x8 qf[NSL];
#pragma unroll
    for (int ds = 0; ds < NSL; ++ds) {
        if (ds < 4) qf[ds] = *WSP(const bf16x8, qa_off + (unsigned)r32 * ldqa + (16 * ds + 8 * hi) * 2);
        else qf[ds] = *WSP(const bf16x8, qb_off + (unsigned)r32 * ldqb + (16 * (ds - 4) + 8 * hi) * 2);
    }
    f32x16 o[2];
#pragma unroll
    for (int i = 0; i < 16; ++i) { o[0][i] = 0.f; o[1][i] = 0.f; }
    float NEG = -1e30f; asm volatile("" : "+s"(NEG));
    float mref;
    const int nt = (kv_hi - kv_lo) >> 6;
#define ATT_DMA(b) do { _Pragma("unroll") for (int j_ = 0; j_ < PPW; ++j_) { \
        __builtin_amdgcn_global_load_lds((const GAS unsigned*)(ws + gsrc[j_]), (LAS unsigned*)(lds + (b) * ATT_BUF + pdst[j_]), 16, 0, 0); gsrc[j_] += pstr[j_]; } } while (0)
#define ATT_WAITBAR(N) asm volatile("s_waitcnt vmcnt(" #N ") lgkmcnt(0)\n\ts_barrier" ::: "memory")
#define ATT_QK(S, bufp, CI) do { \
        bf16x8 kf_[2][NSL]; \
        _Pragma("unroll") for (int kb = 0; kb < 2; ++kb) _Pragma("unroll") for (int ds = 0; ds < NSL; ++ds) kf_[kb][ds] = *(const LAS bf16x8*)((bufp) + (kb * NDS + (ds >> 1)) * 2048 + ((ds & 1) ? foffO : foffE)); \
        __builtin_amdgcn_sched_barrier(0); \
        _Pragma("unroll") for (int ds = 0; ds < NSL; ++ds) _Pragma("unroll") for (int kb = 0; kb < 2; ++kb) \
            S[kb] = __builtin_amdgcn_mfma_f32_32x32x16_bf16(kf_[kb][ds], qf[ds], ds == 0 ? CI : S[kb], 0, 0, 0); } while (0)
#define ATT_MASK(S, kv0) do { if (GQA) { const int qp = qrow + r32; \
        _Pragma("unroll") for (int kb = 0; kb < 2; ++kb) _Pragma("unroll") for (int r = 0; r < 16; ++r) { const int d = qp - ((kv0) + kb * 32 + (r & 3) + 8 * (r >> 2) + 4 * hi); if (d > 128 || d < -128) S[kb][r] = NEG; } } } while (0)
#define MX3(a, b, c) __builtin_fmaxf(__builtin_fmaxf((a), (b)), (c))
#define ATT_LMAX16(V) MX3(MX3(MX3(MX3(MX3(MX3(MX3(V[0], V[1], V[2]), V[3], V[4]), V[5], V[6]), V[7], V[8]), V[9], V[10]), V[11], V[12]), V[13], V[14])
#define ATT_LMAX(S) __builtin_fmaxf(__builtin_fmaxf(ATT_LMAX16(S[0]), S[0][15]), __builtin_fmaxf(ATT_LMAX16(S[1]), S[1][15]))
    ATT_DMA(0); ATT_DMA(1); ATT_DMA(2);
    ATT_WAITBAR(0);
    f32x16 sA[2], sB[2], negm;
#pragma unroll
    for (int i = 0; i < 16; ++i) negm[i] = 0.f;
    ATT_QK(sA, lds, negm);
    ATT_MASK(sA, kv_lo);
    {
        float mx = ATT_LMAX(sA);
        mx = fmaxf(mx, __shfl_xor(mx, 32));
        mref = (mx < -1e29f) ? 0.f : mx;
#pragma unroll
        for (int i = 0; i < 16; ++i) { sA[0][i] -= mref; sA[1][i] -= mref; negm[i] = -mref; }
    }
    const short one_bf = (r32 == 0) ? (short)0x3F80 : (short)0;
    const bf16x8 onesf = {one_bf, one_bf, one_bf, one_bf, one_bf, one_bf, one_bf, one_bf};
    f32x16 lacc;
#pragma unroll
    for (int i = 0; i < 16; ++i) lacc[i] = 0.f;
    int bcur = 0;
#define ATT_STEP(SC, SN, t, has1, ISSUE, WN) do { \
        if (WN) { if (PPW == 3) ATT_WAITBAR(3); else ATT_WAITBAR(2); } else ATT_WAITBAR(0); \
        LAS unsigned char* bufc = lds + bcur * ATT_BUF; \
        if (ISSUE) ATT_DMA((bcur + 3) & 3); \
        if (has1) ATT_QK(SN, lds + ((bcur + 1) & 3) * ATT_BUF, negm); \
        bf16x8 pf[4]; \
        _Pragma("unroll") for (int kb = 0; kb < 2; ++kb) { \
            _Pragma("unroll") for (int r = 0; r < 16; ++r) SC[kb][r] = __builtin_amdgcn_exp2f(SC[kb][r]); \
            _Pragma("unroll") for (int h = 0; h < 2; ++h) { u32x4 w_; w_.x = cvt_pk_bf16(SC[kb][8 * h + 0], SC[kb][8 * h + 1]); w_.y = cvt_pk_bf16(SC[kb][8 * h + 2], SC[kb][8 * h + 3]); \
                w_.z = cvt_pk_bf16(SC[kb][8 * h + 4], SC[kb][8 * h + 5]); w_.w = cvt_pk_bf16(SC[kb][8 * h + 6], SC[kb][8 * h + 7]); pf[2 * kb + h] = __builtin_bit_cast(bf16x8, w_); } } \
        if (has1) ATT_MASK(SN, kv_lo + ((t) + 1) * 64); \
        bf16x8 vf_[2][4]; \
        _Pragma("unroll") for (int db = 0; db < 2; ++db) _Pragma("unroll") for (int sl = 0; sl < 4; ++sl) vf_[db][sl] = *(const LAS bf16x8*)(bufc + 12288 + (db * 2 + (sl >> 1)) * 2048 + ((sl & 1) ? foffO : foffE)); \
        _Pragma("unroll") for (int sl = 0; sl < 4; ++sl) { \
            o[0] = __builtin_amdgcn_mfma_f32_32x32x16_bf16(vf_[0][sl], pf[sl], o[0], 0, 0, 0); \
            o[1] = __builtin_amdgcn_mfma_f32_32x32x16_bf16(vf_[1][sl], pf[sl], o[1], 0, 0, 0); \
            lacc = __builtin_amdgcn_mfma_f32_32x32x16_bf16(onesf, pf[sl], lacc, 0, 0, 0); } \
        if (has1) { \
            const float l0 = ATT_LMAX(SN); \
            if (__builtin_expect(__any(l0 > THR), 0)) { \
                float mx = fmaxf(l0, __shfl_xor(l0, 32)); \
                const float dl = fmaxf(mx, 0.f), f = __builtin_amdgcn_exp2f(-dl); \
                mref += dl; \
                _Pragma("unroll") for (int i = 0; i < 16; ++i) { SN[0][i] -= dl; SN[1][i] -= dl; o[0][i] *= f; o[1][i] *= f; lacc[i] *= f; negm[i] = -mref; } } } \
        bcur = (bcur + 1) & 3; } while (0)
    int t = 0;
    for (; t + 4 < nt; t += 2) {
        ATT_STEP(sA, sB, t, true, true, 1);
        ATT_STEP(sB, sA, t + 1, true, true, 1);
    }
    ATT_STEP(sA, sB, t, true, true, 1);
    ATT_STEP(sB, sA, t + 1, true, false, 1);
    ATT_STEP(sA, sB, t + 2, true, false, 0);
    ATT_STEP(sB, sA, t + 3, false, false, 0);
    ATT_WAITBAR(0);
#undef ATT_STEP
#undef ATT_DMA
#undef ATT_WAITBAR
#undef ATT_QK
#undef ATT_MASK
#undef ATT_LMAX
#undef ATT_LMAX16
#undef MX3
    {
        float l = __shfl(lacc[0], r32);
        if (GQA) l += __builtin_amdgcn_exp2f(sinkl - mref);
        const float rl = 1.0f / l;
#pragma unroll
        for (int db = 0; db < 2; ++db)
#pragma unroll
            for (int g = 0; g < 4; ++g) { u32x2 w; w.x = cvt_pk_bf16(o[db][4 * g] * rl, o[db][4 * g + 1] * rl); w.y = cvt_pk_bf16(o[db][4 * g + 2] * rl, o[db][4 * g + 3] * rl);
                *WSP(u32x2, o_off + (unsigned)r32 * ldqa + (32 * db + 8 * g + 4 * hi) * 2) = w; }
    }
}

struct Args { const float* in[21]; float* out; unsigned char* ws; int ph_lo, ph_hi; };
__device__ __forceinline__ const GAS float* inptr(int i) {
    asm volatile("" : "+s"(i));
    const __attribute__((address_space(4))) unsigned long long* ka = (const __attribute__((address_space(4))) unsigned long long*)__builtin_amdgcn_kernarg_segment_ptr();
    return (const GAS float*)ka[i];
}
__device__ __forceinline__ int prep_col(int kind, int n, int& alt) {
    alt = 0;
    switch (kind) {
    case 0: return n;
    case 1: { const int pn = n >> 8, jj = n & 255; alt = jj >> 7; return 128 * pn + (jj & 127); }
    case 2: {
        if (n < 384) return n;
        if (n < 416) { const int r = n - 384; return 384 + (r >> 1) + ((r & 1) ? 16 : 0); }
        if (n < 512) return -1;
        if (n < 1024) { const int r = n - 512, h = r >> 6, e = r & 63; return 416 + 64 * h + (e >> 1) + ((e & 1) ? 32 : 0); }
        if (n < 1152) { const int r = n - 1024, h = r >> 6, e = r & 63; return 928 + 64 * h + (e >> 1) + ((e & 1) ? 32 : 0); }
        if (n < 1280) return -1;
        return 1184 + (n - 1280); }
    case 3: return n < 128 ? 1056 + n : -1;
    case 4: { const int h = n / 96, e = n - h * 96; if (e < 64) return 96 * h + e; const int r = e - 64; return 96 * h + 64 + (r >> 1) + ((r & 1) ? 16 : 0); }
    case 5: { const int h = n >> 6, e = n & 63; return 128 * h + e; }
    default: { const int h = n >> 6, e = n & 63; return 128 * h + 64 + e; }
    }
}
template <int KIND>
__device__ __forceinline__ void prep_matrix(const GAS float* s0, const GAS float* s1, const GAS float* gain, gptr ws, unsigned dst_off, int K, int pitch, int Nout, LAS float* scr, int gw, int ngw, int lane, int& rot) {
    asm volatile("" : "+s"(dst_off));
    const int nblk = Nout / 32, nitems = (K / 64) * nblk;
    const int first = (gw + ngw - (rot % ngw)) % ngw; rot += nitems;
    for (int it = first; it < nitems; it += ngw) {
        const int kb = it / nblk, nb = it - kb * nblk, k0 = 64 * kb, n0 = 32 * nb;
        int alt; const int col = prep_col(KIND, n0 + (lane & 31), alt);
        const GAS float* sp = (KIND == 1 && alt) ? s1 : s0;
        float vals[32];
        const GAS float* spk = sp + (size_t)(k0 + (lane >> 5)) * pitch + (col >= 0 ? col : 0);
#pragma unroll
        for (int i = 0; i < 32; ++i) vals[i] = spk[(size_t)(2 * i) * pitch];
        const float g0 = gain ? 0.f : 1.f;
#pragma unroll
        for (int i = 0; i < 32; ++i) { const int kk = 2 * i + (lane >> 5); float v = vals[i] * (gain ? gain[k0 + kk] : 1.0f); if (col < 0) v = g0 * 0.f; scr[kk * 33 + (lane & 31)] = v; }
        asm volatile("s_waitcnt lgkmcnt(0)" ::: "memory");
        const int c = lane & 7;
#pragma unroll
        for (int q = 0; q < 4; ++q) { const int n = (lane >> 3) + 8 * q; const LAS float* s = scr + (8 * c) * 33 + n;
            u32x4 o; o.x = cvt_pk_bf16(s[0 * 33], s[1 * 33]); o.y = cvt_pk_bf16(s[2 * 33], s[3 * 33]); o.z = cvt_pk_bf16(s[4 * 33], s[5 * 33]); o.w = cvt_pk_bf16(s[6 * 33], s[7 * 33]);
            *WSP(u32x4, dst_off + ((unsigned)(n0 + n) * K + k0 + 8 * c) * 2) = o; }
        asm volatile("s_waitcnt lgkmcnt(0)" ::: "memory");
    }
}

__device__ __forceinline__ void prep_layer(gptr ws, int l, LAS float* scr, int gw, int ngw, int lane) {
    const size_t oF = (size_t)l * DM * FF, oD = (size_t)l * DM;
    int rot = 0;
    prep_matrix<1>(inptr(3) + oF, inptr(4) + oF, inptr(2) + oD, ws, WS_W + W_13A, DM, FF, 2 * FF, scr, gw, ngw, lane, rot);
    prep_matrix<0>(inptr(5) + oF, nullptr, nullptr, ws, WS_W + W_2A, FF, DM, DM, scr, gw, ngw, lane, rot);
    prep_matrix<1>(inptr(17) + oF, inptr(18) + oF, inptr(16) + oD, ws, WS_W + W_13B, DM, FF, 2 * FF, scr, gw, ngw, lane, rot);
    prep_matrix<0>(inptr(19) + oF, nullptr, nullptr, ws, WS_W + W_2B, FF, DM, DM, scr, gw, ngw, lane, rot);
    prep_matrix<2>(inptr(7) + (size_t)l * DM * 3232, nullptr, inptr(6) + oD, ws, WS_W + W_IN, DM, 3232, 3328, scr, gw, ngw, lane, rot);
    prep_matrix<3>(inptr(7) + (size_t)l * DM * 3232, nullptr, inptr(6) + oD, ws, WS_W + W_GVA, DM, 3232, 256, scr, gw, ngw, lane, rot);
    prep_matrix<4>(inptr(10) + (size_t)l * 256 * 768, nullptr, inptr(8) + (size_t)l * 256, ws, WS_W + W_UQ, 256, 768, 768, scr, gw, ngw, lane, rot);
    prep_matrix<5>(inptr(11) + (size_t)l * 128 * 1024, nullptr, inptr(9) + (size_t)l * 128, ws, WS_W + W_KN, 128, 1024, 512, scr, gw, ngw, lane, rot);
    prep_matrix<6>(inptr(11) + (size_t)l * 128 * 1024, nullptr, inptr(9) + (size_t)l * 128, ws, WS_W + W_VT, 128, 1024, 512, scr, gw, ngw, lane, rot);
    prep_matrix<0>(inptr(12) + (size_t)l * 512 * 1024, nullptr, nullptr, ws, WS_W + W_OA, 512, 1024, 1024, scr, gw, ngw, lane, rot);
    prep_matrix<0>(inptr(14) + (size_t)l * 512 * 1024, nullptr, nullptr, ws, WS_W + W_OB, 512, 1024, 1024, scr, gw, ngw, lane, rot);
    prep_matrix<0>(inptr(15) + (size_t)l * 1024 * 1024, nullptr, nullptr, ws, WS_W + W_OUT, 1024, 1024, 1024, scr, gw, ngw, lane, rot);
}

__device__ __forceinline__ float wave_sum(float v) {
#pragma unroll
    for (int o = 1; o < 64; o <<= 1) v += __shfl_xor(v, o);
    return v;
}

__device__ const float ROPE_FREQ[48] = {1.000000000e+00f, 5.623413324e-01f, 3.162277639e-01f, 1.778279394e-01f, 1.000000015e-01f, 5.623413250e-02f, 3.162277490e-02f, 1.778279431e-02f, 9.999999776e-03f, 5.623413250e-03f, 3.162277630e-03f, 1.778279431e-03f, 1.000000047e-03f, 5.623413017e-04f, 3.162277571e-04f, 1.778279402e-04f, 1.000000000e+00f, 7.498942614e-01f, 5.623413324e-01f, 4.216965139e-01f, 3.162277639e-01f, 2.371373773e-01f, 1.778279394e-01f, 1.333521307e-01f, 1.000000015e-01f, 7.498941571e-02f, 5.623413250e-02f, 4.216965288e-02f, 3.162277490e-02f, 2.371373773e-02f, 1.778279431e-02f, 1.333521493e-02f, 9.999999776e-03f, 7.498941850e-03f, 5.623413250e-03f, 4.216964822e-03f, 3.162277630e-03f, 2.371373586e-03f, 1.778279431e-03f, 1.333521446e-03f, 1.000000047e-03f, 7.498942432e-04f, 5.623413017e-04f, 4.216965172e-04f, 3.162277571e-04f, 2.371373703e-04f, 1.778279402e-04f, 1.333521504e-04f};

#define XB_TMO      128
#define XB_XCNT(j)  (256  + 64 * (j))
#define XB_XSUB(j)  (1280 + 64 * (j))
#define XB_XGEN(j)  (2304 + 64 * (j))
#define XB_TOP      3328
#define XB_TOPGEN   3392
#define XCD_BAR_WORDS 3456
#define XB_SPIN_CAP (1u << 22)
__device__ __forceinline__ unsigned xb_ld(unsigned* p)              { return __hip_atomic_load(p, __ATOMIC_RELAXED, __HIP_MEMORY_SCOPE_AGENT); }
__device__ __forceinline__ unsigned xb_add(unsigned* p, unsigned v) { return __hip_atomic_fetch_add(p, v, __ATOMIC_RELAXED, __HIP_MEMORY_SCOPE_AGENT); }
__device__ __forceinline__ unsigned xb_xcc_id() { return (unsigned)__builtin_amdgcn_s_getreg((3 << 11) | 20) & 0xFu; }
#define XB_SPIN(cond, bar) do { unsigned _sp = 0; while (cond) { __builtin_amdgcn_s_sleep(1); \
    if ((++_sp & 255u) == 0u) { if (xb_ld(&(bar)[XB_TMO])) break; if (_sp > XB_SPIN_CAP) { atomicAdd(&(bar)[XB_TMO], 1u); break; } } } } while (0)
__device__ __forceinline__ void xcd_barrier_complete(unsigned* bar, unsigned x, unsigned& nloc, unsigned& nx) {
    const unsigned G = gridDim.x * gridDim.y * gridDim.z;
    unsigned sum, cnt, mine, sp = 0u;
    for (;;) {
        sum = 0u; cnt = 0u; mine = 0u;
#pragma unroll
        for (unsigned j = 0; j < 16; ++j) { const unsigned c = xb_ld(&bar[XB_XCNT(j)]); sum += c; cnt += (c > 0u) ? 1u : 0u; mine = (j == x) ? c : mine; }
        if (sum == G) break;
        __builtin_amdgcn_s_sleep(1);
        if ((++sp & 255u) == 0u) { if (xb_ld(&bar[XB_TMO])) break; if (sp > XB_SPIN_CAP) { atomicAdd(&bar[XB_TMO], 1u); break; } }
    }
    nloc = mine > 0u ? mine : 1u; nx = cnt > 0u ? cnt : 1u;
}
__device__ __forceinline__ void xcd_barrier(unsigned* bar, unsigned x, volatile LAS unsigned* st) {
    asm volatile("s_waitcnt vmcnt(0)" ::: "memory");
    __syncthreads();
    if (threadIdx.x == 0) {
        __builtin_amdgcn_s_waitcnt(0);
        unsigned nloc = st[0], nx = st[1];
        if (nloc == 0u) { xcd_barrier_complete(bar, x, nloc, nx); st[0] = nloc; st[1] = nx; }
        const unsigned old = xb_add(&bar[XB_XSUB(x)], 1u);
        const unsigned gen = old / nloc;
        if (old + 1u == (gen + 1u) * nloc) {
            __builtin_amdgcn_fence(__ATOMIC_RELEASE, "agent");
            asm volatile("s_waitcnt vmcnt(0)" ::: "memory");
            const unsigned og = xb_add(&bar[XB_TOP], 1u);
            const unsigned tg = og / nx;
            if (og + 1u == (tg + 1u) * nx) xb_add(&bar[XB_TOPGEN], 1u);
            else XB_SPIN(xb_ld(&bar[XB_TOPGEN]) == tg, bar);
            __builtin_amdgcn_fence(__ATOMIC_ACQUIRE, "agent");
            xb_add(&bar[XB_XGEN(x)], 1u);
            asm volatile("s_waitcnt vmcnt(0)" ::: "memory");
        } else {
            XB_SPIN(xb_ld(&bar[XB_XGEN(x)]) == gen, bar);
            __builtin_amdgcn_fence(__ATOMIC_ACQUIRE, "agent");
            asm volatile("s_waitcnt vmcnt(0)" ::: "memory");
        }
    }
    __syncthreads();
}

constexpr int LDS_BYTES = 131072 + 1024;
constexpr size_t WS_BAR = WS_END;
#ifndef PHMASK
#define PHMASK 0xffff
#endif
#define PHM(b) ((PHMASK & (b)) != 0)
constexpr unsigned SS_OFF(int k) { return (unsigned)(WS_SS + (size_t)k * MTOK * 4); }

__global__ void __launch_bounds__(512) fwd_kernel(Args a) {
    extern __shared__ __attribute__((aligned(16))) unsigned char lds_raw[];
    LAS unsigned char* lds = (LAS unsigned char*)lds_raw;
    cg::grid_group grid = cg::this_grid();
    volatile LAS unsigned* bst = (volatile LAS unsigned*)(lds + 131072);
    if (threadIdx.x < 2) bst[threadIdx.x] = 0u;
    unsigned* barw = (unsigned*)(a.ws + WS_BAR);
    const unsigned myxcc = xb_xcc_id();
    if (threadIdx.x == 0) (void)xb_add(&barw[XB_XCNT(myxcc)], 1u);
    __syncthreads();

    for (int ph = a.ph_lo; ph < a.ph_hi; ++ph) {
        int tid = threadIdx.x, G = gridDim.x, bx = blockIdx.x; asm volatile("" : "+v"(tid), "+s"(G), "+s"(bx));
        gptr ws = (gptr)a.ws; gptr X = (gptr)a.out; asm volatile("" : "+s"(ws), "+s"(X));
        const int lane = tid & 63, wave = __builtin_amdgcn_readfirstlane(tid >> 6);
        const int gw = bx * 8 + wave, ngw = G * 8;
        if (PHM(128) && ph == 0) {
            const GAS float* xp = inptr(0); const GAS float* xs = inptr(1);
            for (int m0 = gw; m0 < MTOK; m0 += 2 * ngw) {
                f32x4 v[2][4];
#pragma unroll
                for (int r = 0; r < 2; ++r) { const int m = m0 + r * ngw; const GAS float* src = (m < NPROMPT) ? xp + (size_t)m * DM : xs + (size_t)(m - NPROMPT) * DM;
#pragma unroll
                    for (int jj = 0; jj < 4; ++jj) v[r][jj] = *(const GAS f32x4*)(src + jj * 256 + lane * 4); }
#pragma unroll
                for (int r = 0; r < 2; ++r) { const int m = m0 + r * ngw; float s = 0.f;
#pragma unroll
                    for (int jj = 0; jj < 4; ++jj) { const f32x4 x = v[r][jj];
                        u32x2 w; w.x = cvt_pk_bf16(x[0], x[1]); w.y = cvt_pk_bf16(x[2], x[3]); *WSP(u32x2, WS_XB + (unsigned)m * (DM * 2) + (jj * 256 + lane * 4) * 2) = w;
                        s += (x[0] * x[0] + x[1] * x[1]) + (x[2] * x[2] + x[3] * x[3]); }
                    s = wave_sum(s);
                    if (lane < 16) *WSP(float, SSP_OFF + (unsigned)m * 64u + lane * 4u) = (lane == 0) ? s : 0.f; }
            }
            for (int i = bx * 512 + tid; i < SEQS * 48; i += G * 512) {
                int pos, fi; unsigned dst;
                if (i < SEQS * 16) { pos = i >> 4; fi = i & 15; dst = (unsigned)WS_TAB32 + (unsigned)i * 8u; }
                else { const int k = i - SEQS * 16; pos = k >> 5; fi = 16 + (k & 31); dst = (unsigned)WS_TAB64 + (unsigned)k * 8u; }
                const float ang = (float)pos * ROPE_FREQ[fi];
                const double rev = (double)ang * 0.15915494309189535;
                const float fr_ = (float)(rev - __builtin_rint(rev));
                f32x2 cs; cs.x = __builtin_amdgcn_cosf(fr_); cs.y = __builtin_amdgcn_sinf(fr_); *WSP(f32x2, dst) = cs;
            }
            prep_layer(ws, 0, (LAS float*)(lds + wave * 16384), gw, ngw, lane);
        } else if (ph >= 1000) {
            const int code = ph - 1000;
            unsigned offA, pitA, offB, pitB;
            if (code == 0) { offA = WS_MIX + MX_QN; pitA = 1024; offB = WS_MIX + MX_GQ; pitB = 1024; }
            else if (code == 1) { offA = WS_MIX + MX_KN; pitA = 1024; offB = WS_MIX + MX_QP; pitB = 512; }
            else if (code == 2) { offA = WS_MIX + MX_GA; pitA = 2048; offB = WS_MIX + MX_GB; pitB = 2048; }
            else if (code == 3) { offA = WS_MIX + MX_CQ; pitA = 512; offB = WS_MIX + MX_CKV; pitB = 512; }
            else { offA = WS_MIX + MX_VT; pitA = 1024; offB = WS_MIX + MX_GVT; pitB = 256; }
            for (int m = gw; m < MTOK; m += ngw) {
#pragma unroll
                for (int half = 0; half < 2; ++half) {
                    const unsigned so = (half ? offB + (unsigned)m * pitB : offA + (unsigned)m * pitA) + lane * 16;
                    const u32x4 w = *WSP(const u32x4, so); f32x4 a0, a1; unpack8(w, a0, a1);
                    GAS f32x4* dp = (GAS f32x4*)(X + (unsigned)(m * 4096 + half * 2048 + lane * 32)); dp[0] = a0; dp[1] = a1;
                }
            }
        } else if (ph == NPHASE - 1) {
            const GAS float* g = inptr(20);
            for (int m = gw; m < MTOK; m += ngw) {
                const float rs = rstd(sum16(ws, SSP_OFF, m), 1.0f / DM);
#pragma unroll
                for (int jj = 0; jj < 4; ++jj) { GAS f32x4* p = (GAS f32x4*)(X + (unsigned)(m * (DM * 4) + (jj * 256 + lane * 4) * 4)); const f32x4 gv = *(const GAS f32x4*)(g + jj * 256 + lane * 4);
                    const u32x2 w = *WSP(const u32x2, WS_XB + (unsigned)m * (DM * 2) + (jj * 256 + lane * 4) * 2);
                    f32x4 xv; xv[0] = __uint_as_float(w.x << 16); xv[1] = __uint_as_float(w.x & 0xffff0000u); xv[2] = __uint_as_float(w.y << 16); xv[3] = __uint_as_float(w.y & 0xffff0000u);
                    *p = xv * rs * gv; }
            }
        } else if (ph > 0) {
            const int l = (ph - 1) / 10, sub = (ph - 1) % 10;
            pg8::StaticOrder S;
            if (PHM(1) && (sub == 0 || sub == 7)) {
                pg8::Gemm g{WSP(const bf16_t, WS_XB), WSP(const bf16_t, WS_W + (sub == 0 ? W_13A : W_13B)), MTOK, 2 * FF, DM, DM, DM}; S.init(MTOK, 2 * FF, G, bx);
                EpiSwiglu E{ws};
                pg8::gemm_phase(lds, g, S, E);
            } else if (PHM(2) && (sub == 1 || sub == 8)) {
                pg8::Gemm g{WSP(const bf16_t, WS_MIX), WSP(const bf16_t, WS_W + (sub == 1 ? W_2A : W_2B)), MTOK, DM, FF, FF, FF}; S.init(MTOK, DM, G, bx, 1);
                EpiResid E{ws, 0.5f};
                pg8::gemm_phase(lds, g, S, E);
            } else if (PHM(4) && sub == 2) {
                { pg8::Gemm g{WSP(const bf16_t, WS_XB), WSP(const bf16_t, WS_W + W_IN), MTOK, 3328, DM, DM, DM}; S.init(MTOK, 3328, G, bx);
                  EpiWin E{ws};
                  pg8::gemm_phase(lds, g, S, E); }
                { pg8::Gemm g{WSP(const bf16_t, WS_W + W_GVA), WSP(const bf16_t, WS_XB), 256, MTOK, DM, DM, DM}; S.init(256, MTOK, G, (bx + (G >> 1)) % G);
                  EpiVt E{ws, 1, 1.0f / DM, (unsigned)(WS_MIX + MX_GVT), 1};
                  pg8::gemm_phase(lds, g, S, E); }
            } else if (PHM(8) && sub == 3) {
#ifndef S3
#define S3 7
#endif
                if (S3 & 1) { pg8::Gemm g{WSP(const bf16_t, WS_MIX + MX_CQ), WSP(const bf16_t, WS_W + W_UQ), MTOK, 768, 256, 256, 256}; S.init(MTOK, 768, G, bx);
                  EpiQ E{ws};
                  pg8::gemm_phase(lds, g, S, E); }
                if (S3 & 2) { pg8::Gemm g{WSP(const bf16_t, WS_MIX + MX_CKV), WSP(const bf16_t, WS_W + W_KN), MTOK, 512, 128, 256, 128}; S.init(MTOK, 512, G, bx);
                  EpiKn E{ws};
                  pg8::gemm_phase(lds, g, S, E); }
                if (S3 & 4) { pg8::Gemm g{WSP(const bf16_t, WS_W + W_VT), WSP(const bf16_t, WS_MIX + MX_CKV), 512, MTOK, 128, 128, 256}; S.init(512, MTOK, G, bx);
                  EpiVt E{ws, 0, 1.0f / 128.0f, (unsigned)(WS_MIX + MX_VT), 2};
                  pg8::gemm_phase(lds, g, S, E); }
            } else if (PHM(16) && sub == 4) {
#ifndef ATT_REPS
#define ATT_REPS 1
#endif
                for (int rep = 0; rep < ATT_REPS; ++rep) {
                const int xcd = bx & 7, idx = bx >> 3, per = G >> 3;
                const int h = xcd;
                for (int u = idx; u < 128; u += per) {
                    int row, lo, hi;
                    if (u < 64) { row = NPROMPT + u * 256 + wave * 32; lo = NPROMPT; hi = MTOK; }
                    else { const int v = u - 64, sq = v >> 3; row = sq * SEQP + (v & 7) * 256 + wave * 32; lo = sq * SEQP; hi = lo + SEQP; }
                    ATTN_FN<3, false>(lds, ws, (unsigned)(WS_MIX + MX_QN) + (unsigned)row * 1024 + h * 128, 1024, (unsigned)(WS_MIX + MX_QP) + (unsigned)row * 512 + h * 64, 512, row,
                        (unsigned)(WS_MIX + MX_KN) + h * 128, 1024, (unsigned)(WS_MIX + MX_CKV) + 256, 512, (unsigned)(WS_MIX + MX_VT) + (unsigned)(h * 64) * (MTOK * 2), lo, hi, 0.f, (rep == 0 && ATT_REPS > 1) ? (unsigned)WS_XB + (unsigned)row * 1024 + h * 128 : (unsigned)(WS_MIX + MX_QN) + (unsigned)row * 1024 + h * 128);
                }
                const GAS float* sink = inptr(13) + l * 8;
                for (int u = bx; u < 1024; u += G) {
                    const int blk = u >> 2, kh = (u >> 1) & 1, hp = u & 1, head = kh * 4 + hp * 2 + (wave >> 2);
                    const int q0 = blk * 128, row = q0 + (wave & 3) * 32;
                    const int s_lo = q0 < NPROMPT ? (q0 & ~(SEQP - 1)) : NPROMPT, s_hi = q0 < NPROMPT ? s_lo + SEQP : MTOK;
                    const int lo = (q0 - 128 > s_lo) ? q0 - 128 : s_lo, hi = (q0 + 256 < s_hi) ? q0 + 256 : s_hi;
                    ATTN_FN<2, true>(lds, ws, (unsigned)(WS_MIX + MX_GQ) + (unsigned)row * 1024 + head * 128, 1024, 0, 0, row,
                        (unsigned)(WS_MIX + MX_GK) + kh * 128, 256, 0, 0, (unsigned)(WS_MIX + MX_GVT) + (unsigned)(kh * 64) * (MTOK * 2), lo, hi, sink[head] * LOG2E, (rep == 0 && ATT_REPS > 1) ? (unsigned)(WS_XB + 32 * MiB) + (unsigned)row * 1024 + head * 128 : (unsigned)(WS_MIX + MX_GQ) + (unsigned)row * 1024 + head * 128);
                }
                }
            } else if (PHM(32) && sub == 5) {
                { pg8::Gemm g{WSP(const bf16_t, WS_MIX + MX_GQ), WSP(const bf16_t, WS_W + W_OB), MTOK, DM, 1024, 512, 512, WSP(const bf16_t, WS_MIX + MX_QN), WSP(const bf16_t, WS_W + W_OA), 8}; S.init(MTOK, DM, G, bx);
                  EpiGateDual E{ws};
                  pg8::gemm_phase(lds, g, S, E); }
            } else if (PHM(64) && sub == 6) {
                pg8::Gemm g{WSP(const bf16_t, WS_MIX + MX_GA), WSP(const bf16_t, WS_W + W_OUT), MTOK, DM, DM, DM, DM}; S.init(MTOK, DM, G, bx, 1);
                EpiResid E{ws, 1.0f};
                pg8::gemm_phase(lds, g, S, E);
            } else if (PHM(256) && sub == 9) {
                if (l + 1 < NL) prep_layer(ws, l + 1, (LAS float*)(lds + wave * 16384), gw, ngw, lane);
            }
        }
        if (ph + 1 < a.ph_hi) { if (a.ph_hi > 1000000) grid.sync(); else xcd_barrier(barw, myxcc, bst); }
    }
}

extern "C" void kernel_launch(void* const* d_in, const int* in_sizes, int n_in, void* d_out, int out_size, void* d_ws, size_t ws_size, hipStream_t stream) {
    static int grid = 0;
    if (grid == 0) {
        if (n_in != 21 || out_size != MTOK * DM || ws_size < WS_END + 65536) { fprintf(stderr, "kernel_launch: unexpected shapes (n_in %d out %d ws %zu)\n", n_in, out_size, ws_size); grid = -1; return; }
        int dev = 0, cus = 0, per_cu = 0;
        (void)hipGetDevice(&dev); (void)hipDeviceGetAttribute(&cus, hipDeviceAttributeMultiprocessorCount, dev);
        (void)hipFuncSetAttribute((const void*)fwd_kernel, hipFuncAttributeMaxDynamicSharedMemorySize, LDS_BYTES);
        (void)hipOccupancyMaxActiveBlocksPerMultiprocessor(&per_cu, (const void*)fwd_kernel, 512, LDS_BYTES);
        (void)hipGetLastError();
        grid = cus;
        if (grid <= 0 || grid % 8 != 0 || grid > 512) grid = 256;
    }
    if (grid < 0) return;
    (void)hipMemsetAsync((char*)d_ws + WS_BAR, 0, 16384, stream);
    Args a{};
    for (int i = 0; i < 21; ++i) a.in[i] = (const float*)d_in[i];
    a.out = (float*)d_out; a.ws = (unsigned char*)d_ws;
#ifndef ONE_LAUNCH
#define ONE_LAUNCH 1
#endif
#if ONE_LAUNCH
    a.ph_lo = 0; a.ph_hi = NPHASE;
    void* args[] = {&a};
    hipError_t e = hipLaunchCooperativeKernel((const void*)fwd_kernel, dim3(grid), dim3(512), args, LDS_BYTES, stream);
    if (e != hipSuccess) fprintf(stderr, "cooperative launch failed: %s (grid %d)\n", hipGetErrorString(e), grid);
#else
#ifndef DBG_STOP
#define DBG_STOP -1
#endif
#ifndef DBG_DUMP
#define DBG_DUMP -1
#endif
    for (int ph = 0; ph < NPHASE; ++ph) {
        if (DBG_STOP >= 0 && ph > DBG_STOP) break;
        a.ph_lo = ph; a.ph_hi = ph + 1;
        hipLaunchKernelGGL(fwd_kernel, dim3(grid), dim3(512), LDS_BYTES, stream, a);
    }
    if (DBG_DUMP >= 0) { a.ph_lo = 1000 + DBG_DUMP; a.ph_hi = a.ph_lo + 1; hipLaunchKernelGGL(fwd_kernel, dim3(grid), dim3(512), LDS_BYTES, stream, a); }
#endif
}
```
